# Optimizing an MI355X kernel written in HIP

```python
import jax
import jax.numpy as jnp
from jax import lax
import numpy as np

D_MODEL = 1024
BATCH = 8
SEQ = 4096
DEPTH = 1

HEAD_DIM = 64
N_HEADS_DIL = 8
DILATED_CONFIGS = ((128, 1), (512, 4), (2048, 16))
N_HEADS_SWA = 8
N_KV_SWA = 2
SWA_WINDOW = 128
ATTN_BLOCK = 128
ROPE_THETA = 10000.0
N_EXPERTS = 32
TOP_K = 4
D_FF = D_MODEL
SWIGLU_ALPHA = 1.702
SWIGLU_LIMIT = 7.0
EXPERT_BLOCK = 512
NORM_EPS = 1e-5

W_DIL = N_HEADS_DIL * HEAD_DIM
W_SWA = N_HEADS_SWA * HEAD_DIM
W_KV_SWA = N_KV_SWA * HEAD_DIM
D_MIX = W_DIL + W_SWA
D_IN = 3 * W_DIL + W_SWA + 2 * W_KV_SWA
SPLITS = [W_DIL, 2 * W_DIL, 3 * W_DIL, 3 * W_DIL + W_SWA, 3 * W_DIL + W_SWA + W_KV_SWA]

kernel_name = 'hybrid_dilated_swa_sink_moe_block'


def rmsnorm(x, g):
    xf = x.astype(jnp.float32)
    y = xf * lax.rsqrt(jnp.mean(xf * xf, axis=-1, keepdims=True) + NORM_EPS)
    return (y * g.astype(jnp.float32)).astype(x.dtype)


def rope_tables(positions):
    inv = ROPE_THETA ** (-jnp.arange(0, HEAD_DIM, 2, dtype=jnp.float32) / HEAD_DIM)
    ang = positions.astype(jnp.float32)[..., None] * inv
    return jnp.cos(ang)[:, :, None, :], jnp.sin(ang)[:, :, None, :]


def apply_rope(t, cos, sin):
    tf = t.astype(jnp.float32)
    half = HEAD_DIM // 2
    t1, t2 = tf[..., :half], tf[..., half:]
    return jnp.concatenate([t1 * cos - t2 * sin, t2 * cos + t1 * sin], axis=-1).astype(t.dtype)


def banded_attention(q, k, v, max_dist):
    bsz, nk, ng, length, hd = q.shape
    nb = -(-length // ATTN_BLOCK)
    pad = nb * ATTN_BLOCK - length
    if pad:
        q = jnp.pad(q, ((0, 0), (0, 0), (0, 0), (0, pad), (0, 0)))
        k = jnp.pad(k, ((0, 0), (0, 0), (0, pad), (0, 0)))
        v = jnp.pad(v, ((0, 0), (0, 0), (0, pad), (0, 0)))
    lp = nb * ATTN_BLOCK

    def two_blocks(t):
        prev = jnp.pad(t, ((0, 0), (0, 0), (ATTN_BLOCK, 0), (0, 0)))[:, :, :lp]
        return jnp.concatenate([prev.reshape(bsz, nk, nb, ATTN_BLOCK, hd),
                                t.reshape(bsz, nk, nb, ATTN_BLOCK, hd)], axis=3)

    kb, vb = two_blocks(k), two_blocks(v)
    qb = q.reshape(bsz, nk, ng, nb, ATTN_BLOCK, hd)
    s = jnp.einsum('bkgnqd,bknsd->bkgnqs', qb, kb,
                   preferred_element_type=jnp.float32) * (hd ** -0.5)
    qi = jnp.arange(ATTN_BLOCK)[:, None]
    kj = jnp.arange(2 * ATTN_BLOCK)[None, :]
    dist = qi - kj + ATTN_BLOCK
    blk = jnp.arange(nb)[:, None, None]
    mask = (dist >= 0) & (dist <= max_dist) & ((blk > 0) | (kj >= ATTN_BLOCK))
    s = jnp.where(mask, s, -jnp.inf)
    m = jnp.max(s, axis=-1, keepdims=True)
    p = jnp.exp(s - m)
    l = jnp.sum(p, axis=-1, keepdims=True)
    o = jnp.einsum('bkgnqs,bknsd->bkgnqd', p, vb.astype(jnp.float32)) / l
    lse = (m + jnp.log(l))[..., 0]
    o = o.reshape(bsz, nk, ng, lp, hd)[:, :, :, :length]
    lse = lse.reshape(bsz, nk, ng, lp)[:, :, :, :length]
    return o, lse


def dilated_attention(q, k, v):
    bsz, nh, seq, hd = q.shape
    outs, lses = [], []
    for window, r in DILATED_CONFIGS:
        length = seq // r

        def by_residue(t):
            return t.reshape(bsz, nh, length, r, hd).transpose(0, 1, 3, 2, 4).reshape(bsz, nh * r, length, hd)

        o, lse = banded_attention(by_residue(q)[:, :, None], by_residue(k), by_residue(v), window // r)
        outs.append(o[:, :, 0].reshape(bsz, nh, r, length, hd).transpose(0, 1, 3, 2, 4).reshape(bsz, nh, seq, hd))
        lses.append(lse[:, :, 0].reshape(bsz, nh, r, length).transpose(0, 1, 3, 2).reshape(bsz, nh, seq))
    wts = jax.nn.softmax(jnp.stack(lses), axis=0)
    return jnp.sum(wts[..., None] * jnp.stack(outs), axis=0).astype(q.dtype)


def sink_sliding_attention(q, k, v, sinks):
    bsz, nq, seq, hd = q.shape
    g = nq // N_KV_SWA
    o, lse = banded_attention(q.reshape(bsz, N_KV_SWA, g, seq, hd), k, v, SWA_WINDOW - 1)
    sink = sinks.astype(jnp.float32).reshape(N_KV_SWA, g)[None, :, :, None]
    o = o * jax.nn.sigmoid(lse - sink)[..., None]
    return o.reshape(bsz, nq, seq, hd).astype(q.dtype)


def hybrid_mixer(h, cos, sin, w_in, b_in, sinks, gn_dil, gn_swa, w_out, b_out):
    bsz, seq, _ = h.shape
    proj = jnp.dot(h, w_in) + b_in
    qa, ka, va, qb, kb, vb = jnp.split(proj, SPLITS, axis=-1)

    def heads(t, n, rot):
        t = t.reshape(bsz, seq, n, HEAD_DIM)
        if rot:
            t = apply_rope(t, cos, sin)
        return t.transpose(0, 2, 1, 3)

    o_dil = dilated_attention(heads(qa, N_HEADS_DIL, True), heads(ka, N_HEADS_DIL, True),
                              heads(va, N_HEADS_DIL, False))
    o_swa = sink_sliding_attention(heads(qb, N_HEADS_SWA, True), heads(kb, N_KV_SWA, True),
                                   heads(vb, N_KV_SWA, False), sinks)
    o_dil = o_dil.transpose(0, 2, 1, 3).reshape(bsz, seq, W_DIL)
    o_swa = o_swa.transpose(0, 2, 1, 3).reshape(bsz, seq, W_SWA)
    mixed = jnp.concatenate([rmsnorm(o_dil, gn_dil), rmsnorm(o_swa, gn_swa)], axis=-1).astype(h.dtype)
    return jnp.dot(mixed, w_out) + b_out


def clamped_swiglu(u):
    glu, lin = u[..., ::2], u[..., 1::2]
    glu = jnp.minimum(glu, SWIGLU_LIMIT)
    lin = jnp.clip(lin, -SWIGLU_LIMIT, SWIGLU_LIMIT)
    return glu * jax.nn.sigmoid(SWIGLU_ALPHA * glu) * (lin + 1.0)


def moe(h, w_router, b_router, w1, b1, w2, b2):
    bsz, seq, d = h.shape
    t = h.reshape(-1, d)
    ntok = t.shape[0]
    logits = jnp.dot(t, w_router, preferred_element_type=jnp.float32) + b_router.astype(jnp.float32)
    top_val, top_idx = lax.top_k(logits, TOP_K)
    gates = jax.nn.softmax(top_val, axis=-1)
    n_assign = ntok * TOP_K
    flat_e = top_idx.reshape(-1)
    flat_tok = jnp.arange(n_assign, dtype=jnp.int32) // TOP_K
    flat_g = gates.reshape(-1)
    order = jnp.argsort(flat_e)
    sorted_e = flat_e[order]
    counts = jnp.bincount(flat_e, length=N_EXPERTS)
    padded = (counts + EXPERT_BLOCK - 1) // EXPERT_BLOCK * EXPERT_BLOCK
    starts = jnp.cumsum(counts) - counts
    pad_ends = jnp.cumsum(padded)
    pad_starts = pad_ends - padded
    dest = pad_starts[sorted_e] + (jnp.arange(n_assign, dtype=jnp.int32) - starts[sorted_e])
    n_slots = (n_assign + N_EXPERTS * EXPERT_BLOCK + EXPERT_BLOCK - 1) // EXPERT_BLOCK * EXPERT_BLOCK
    n_blocks = n_slots // EXPERT_BLOCK
    slot_tok = jnp.zeros((n_slots,), jnp.int32).at[dest].set(flat_tok[order])
    slot_gate = jnp.zeros((n_slots,), jnp.float32).at[dest].set(flat_g[order])
    block_e = jnp.minimum(jnp.searchsorted(pad_ends, jnp.arange(n_blocks) * EXPERT_BLOCK, side='right'),
                          N_EXPERTS - 1)
    xs = t[slot_tok].reshape(n_blocks, EXPERT_BLOCK, d)

    def expert_block(args):
        xb, e = args
        hid = clamped_swiglu(jnp.dot(xb, w1[e]) + b1[e])
        return jnp.dot(hid, w2[e]) + b2[e]

    ys = lax.map(expert_block, (xs, block_e)).reshape(n_slots, d)
    out = jax.ops.segment_sum(ys.astype(jnp.float32) * slot_gate[:, None], slot_tok, num_segments=ntok)
    return out.reshape(bsz, seq, d).astype(h.dtype)


def setup_inputs(seed: int = 0) -> dict:
    key = jax.random.key(seed)
    ks = jax.random.split(key, 20)
    f32 = jnp.float32

    def nrm(k, shape, scale):
        return jax.random.normal(k, shape, f32) * scale

    x = nrm(ks[0], (BATCH, SEQ, D_MODEL), 1.0)
    offset = jax.random.randint(ks[1], (BATCH, 1), 0, 1024, dtype=jnp.int32)
    positions = offset + jnp.arange(SEQ, dtype=jnp.int32)[None, :]
    return {
        'x': x,
        'positions': positions,
        'norm1_g': 1.0 + nrm(ks[2], (DEPTH, D_MODEL), 0.02),
        'w_in': nrm(ks[3], (DEPTH, D_MODEL, D_IN), D_MODEL ** -0.5),
        'b_in': nrm(ks[4], (DEPTH, D_IN), 0.02),
        'sinks': nrm(ks[5], (DEPTH, N_HEADS_SWA), 1.0),
        'gn_dil': 1.0 + nrm(ks[6], (DEPTH, W_DIL), 0.02),
        'gn_swa': 1.0 + nrm(ks[7], (DEPTH, W_SWA), 0.02),
        'w_out': nrm(ks[8], (DEPTH, D_MIX, D_MODEL), D_MIX ** -0.5),
        'b_out': nrm(ks[9], (DEPTH, D_MODEL), 0.02),
        'norm2_g': 1.0 + nrm(ks[10], (DEPTH, D_MODEL), 0.02),
        'w_router': nrm(ks[11], (DEPTH, D_MODEL, N_EXPERTS), D_MODEL ** -0.5),
        'b_router': nrm(ks[12], (DEPTH, N_EXPERTS), 0.01),
        'w_mlp1': nrm(ks[13], (DEPTH, N_EXPERTS, D_MODEL, 2 * D_FF), D_MODEL ** -0.5),
        'b_mlp1': nrm(ks[14], (DEPTH, N_EXPERTS, 2 * D_FF), 0.02),
        'w_mlp2': nrm(ks[15], (DEPTH, N_EXPERTS, D_FF, D_MODEL), D_FF ** -0.5),
        'b_mlp2': nrm(ks[16], (DEPTH, N_EXPERTS, D_MODEL), 0.02),
        'norm_f_g': 1.0 + nrm(ks[17], (D_MODEL,), 0.02),
    }


def reference(x, positions, norm1_g, w_in, b_in, sinks, gn_dil, gn_swa, w_out, b_out,
              norm2_g, w_router, b_router, w_mlp1, b_mlp1, w_mlp2, b_mlp2, norm_f_g):
    cos, sin = rope_tables(positions)
    for layer in range(DEPTH):
        h = rmsnorm(x, norm1_g[layer])
        x = x + hybrid_mixer(h, cos, sin, w_in[layer], b_in[layer], sinks[layer], gn_dil[layer],
                             gn_swa[layer], w_out[layer], b_out[layer]).astype(x.dtype)
        h = rmsnorm(x, norm2_g[layer])
        x = x + moe(h, w_router[layer], b_router[layer], w_mlp1[layer], b_mlp1[layer],
                    w_mlp2[layer], b_mlp2[layer]).astype(x.dtype)
    return rmsnorm(x, norm_f_g)
```

```cpp
#include <hip/hip_runtime.h>
#include <cstdio>
#include <cstdint>

#define LAS __attribute__((address_space(3)))
typedef unsigned short bf16_t;
typedef short bf16x8 __attribute__((ext_vector_type(8)));
typedef float f32x4 __attribute__((ext_vector_type(4)));
typedef unsigned u32x4 __attribute__((ext_vector_type(4)));
typedef unsigned u32x2 __attribute__((ext_vector_type(2)));

constexpr int BATCH = 8, SEQ = 4096, DM = 1024, NTOK = BATCH * SEQ;
constexpr int HD = 64, D_IN = 2304;
constexpr int NEXP = 32, DFF = 1024, DU = 2048;
constexpr float EPS = 1e-5f;
constexpr float LOG2E = 1.4426950408889634f;
constexpr float QSCALE = 0.125f * LOG2E;

constexpr size_t MiB = 1u << 20;
constexpr size_t WS_CTL = 0, CTL_BYTES = 1 * MiB;
constexpr size_t WS_WIN = 2 * MiB;
constexpr size_t WS_WOUT = 8 * MiB;
constexpr size_t WS_W1 = 16 * MiB;
constexpr size_t WS_W2 = 144 * MiB;
constexpr size_t WS_H1 = 208 * MiB;
constexpr size_t WS_QKV = 272 * MiB;
constexpr size_t WS_PART = 416 * MiB;
constexpr size_t WS_OSWA = 512 * MiB;
constexpr size_t WS_LSE = 544 * MiB;
constexpr size_t WS_MIXED = 548 * MiB;
constexpr size_t WS_H2 = 612 * MiB;
constexpr size_t WS_TOKL = 676 * MiB;
constexpr size_t WS_ASSIGN = 680 * MiB;
constexpr size_t WS_GATE = 680 * MiB + 512 * 1024;
constexpr size_t WS_HID = 682 * MiB;
constexpr size_t WS_ROPE = 954 * MiB;
constexpr size_t WS_END = 962 * MiB;
constexpr size_t WS_Y = 208 * MiB;
constexpr int CW_CNT = 1024;

struct Params {
    const float* x; const int* pos; const float* g1; const float* w_in; const float* b_in; const float* sinks;
    const float* gn_dil; const float* gn_swa; const float* w_out; const float* b_out; const float* g2;
    const float* w_router; const float* b_router; const float* w1; const float* b1; const float* w2; const float* b2; const float* gf;
    float* out; unsigned char* ws;
};

__device__ __forceinline__ unsigned f2bf(float f) { unsigned u = __builtin_bit_cast(unsigned, f); return (u + 0x7fffu + ((u >> 16) & 1u)) >> 16; }
__device__ __forceinline__ unsigned pk2(float lo, float hi) { return f2bf(lo) | (f2bf(hi) << 16); }
__device__ __forceinline__ float bf2f(unsigned h) { return __builtin_bit_cast(float, h << 16); }
__device__ __forceinline__ float bflo(unsigned w) { return __builtin_bit_cast(float, w << 16); }
__device__ __forceinline__ float bfhi(unsigned w) { return __builtin_bit_cast(float, w & 0xffff0000u); }
__device__ __forceinline__ float wave_sum(float v) {
#pragma unroll
    for (int o = 1; o < 64; o <<= 1) v += __shfl_xor(v, o);
    return v;
}
__host__ __device__ __forceinline__ int qkv_phys32(int n0) { const int pn = n0 >> 8, w = n0 & 255, hh = w >> 6, bj = (w >> 5) & 1; return (pn << 8) + (bj << 7) + (hh << 5); }

__device__ __forceinline__ void transpose_item(const float* W, int K, int N, bf16_t* WT, bool perm, LAS float* scr, int item, int lane) {
    const int nblk = N / 32, kb = item / nblk, nb = item % nblk, k0 = 64 * kb, n0 = 32 * nb;
#pragma unroll 8
    for (int i = 0; i < 32; ++i) { const int kk = 2 * i + (lane >> 5); scr[kk * 33 + (lane & 31)] = W[(size_t)(k0 + kk) * N + n0 + (lane & 31)]; }
    asm volatile("s_waitcnt lgkmcnt(0)" ::: "memory");
    const int c = lane & 7;
    const int ob = perm ? qkv_phys32(n0) : n0;
#pragma unroll
    for (int j = 0; j < 4; ++j) { const int n = (lane >> 3) + 8 * j; const LAS float* s = scr + (8 * c) * 33 + n;
        u32x4 o; o.x = pk2(s[0 * 33], s[1 * 33]); o.y = pk2(s[2 * 33], s[3 * 33]); o.z = pk2(s[4 * 33], s[5 * 33]); o.w = pk2(s[6 * 33], s[7 * 33]);
        *(u32x4*)(WT + (size_t)(ob + n) * K + k0 + 8 * c) = o; }
    asm volatile("s_waitcnt lgkmcnt(0)" ::: "memory");
}

__device__ __forceinline__ void p0_prologue(const Params& P, int gw, int ngw, int lane, LAS float* scr) {
    unsigned char* ws = P.ws;
    bf16_t* WIN = (bf16_t*)(ws + WS_WIN); bf16_t* WOUT = (bf16_t*)(ws + WS_WOUT); bf16_t* W1T = (bf16_t*)(ws + WS_W1); bf16_t* W2T = (bf16_t*)(ws + WS_W2);
    constexpr int I_IN = (DM / 64) * (D_IN / 32), I_OUT = (DM / 64) * (DM / 32), I_1 = (DM / 64) * (DU / 32), I_2 = (DFF / 64) * (DM / 32);
    constexpr int NITEMS = I_IN + I_OUT + NEXP * (I_1 + I_2);
    for (int it = gw; it < NITEMS; it += ngw) {
        int r = it;
        if (r < I_IN) { transpose_item(P.w_in, DM, D_IN, WIN, true, scr, r, lane); continue; } r -= I_IN;
        if (r < I_OUT) { transpose_item(P.w_out, DM, DM, WOUT, false, scr, r, lane); continue; } r -= I_OUT;
        if (r < NEXP * I_1) { const int e = r / I_1; transpose_item(P.w1 + (size_t)e * DM * DU, DM, DU, W1T + (size_t)e * DU * DM, false, scr, r % I_1, lane); continue; } r -= NEXP * I_1;
        { const int e = r / I_2; transpose_item(P.w2 + (size_t)e * DFF * DM, DFF, DM, W2T + (size_t)e * DM * DFF, false, scr, r % I_2, lane); }
    }
    bf16_t* H1 = (bf16_t*)(ws + WS_H1);
    for (int t = gw; t < NTOK; t += ngw) {
        const f32x4* xr = (const f32x4*)(P.x + (size_t)t * DM) + lane; const f32x4* gr = (const f32x4*)P.g1 + lane;
        f32x4 v[4]; float ss = 0.f;
#pragma unroll
        for (int j = 0; j < 4; ++j) { v[j] = xr[64 * j]; ss += (v[j].x * v[j].x + v[j].y * v[j].y) + (v[j].z * v[j].z + v[j].w * v[j].w); }
        const float rstd = 1.0f / sqrtf(wave_sum(ss) * (1.0f / DM) + EPS);
        u32x2* o = (u32x2*)(H1 + (size_t)t * DM) + lane;
#pragma unroll
        for (int j = 0; j < 4; ++j) { const f32x4 g = gr[64 * j]; u32x2 w; w.x = pk2(v[j].x * rstd * g.x, v[j].y * rstd * g.y); w.y = pk2(v[j].z * rstd * g.z, v[j].w * rstd * g.w); o[64 * j] = w; }
    }
    float* RC = (float*)(ws + WS_ROPE); float* RS = RC + (size_t)NTOK * 32;
    for (int idx = gw * 64 + lane; idx < NTOK * 32; idx += ngw * 64) {
        const int t = idx >> 5, i = idx & 31;
        const float inv = (float)exp2(-(double)i * (13.287712379549449 / 32.0));
        const float ang = (float)P.pos[t] * inv;
        const double a = (double)ang * 0.15915494309189535;
        const float fr = (float)(a - rint(a));
        RC[idx] = __builtin_amdgcn_cosf(fr); RS[idx] = __builtin_amdgcn_sinf(fr);
    }
}

template <class ARow, class BRow>
__device__ __forceinline__ void wave_gemm64(f32x4 (&acc)[4][4], ARow arow, BRow brow, int K, int lane) {
    const int r16 = lane & 15, q = lane >> 4;
    const bf16_t* ap[4]; const bf16_t* bp[4];
#pragma unroll
    for (int m = 0; m < 4; ++m) ap[m] = arow(m, r16) + 8 * q;
#pragma unroll
    for (int n = 0; n < 4; ++n) bp[n] = brow(n, r16) + 8 * q;
#pragma unroll
    for (int m = 0; m < 4; ++m)
#pragma unroll
        for (int n = 0; n < 4; ++n) acc[m][n] = (f32x4){0.f, 0.f, 0.f, 0.f};
#pragma unroll 2
    for (int k0 = 0; k0 < K; k0 += 32) {
        bf16x8 a[4], b[4];
#pragma unroll
        for (int m = 0; m < 4; ++m) a[m] = *(const bf16x8*)(ap[m] + k0);
#pragma unroll
        for (int n = 0; n < 4; ++n) b[n] = *(const bf16x8*)(bp[n] + k0);
#pragma unroll
        for (int m = 0; m < 4; ++m)
#pragma unroll
            for (int n = 0; n < 4; ++n) acc[m][n] = __builtin_amdgcn_mfma_f32_16x16x32_bf16(b[n], a[m], acc[m][n], 0, 0, 0);
    }
}

__device__ __forceinline__ void p1_qkv(const Params& P, int gw, int ngw, int lane) {
    unsigned char* ws = P.ws;
    const bf16_t* H1 = (const bf16_t*)(ws + WS_H1); const bf16_t* WIN = (const bf16_t*)(ws + WS_WIN); bf16_t* QKV = (bf16_t*)(ws + WS_QKV);
    const float* RC = (const float*)(ws + WS_ROPE); const float* RS = RC + (size_t)NTOK * 32;
    const int q4 = lane >> 4, r16l = lane & 15;
    constexpr int NU = (NTOK / 64) * 36;
    for (int u = gw; u < NU; u += ngw) {
        const int hs = u % 36, rt = u / 36, row0 = rt * 64;
        const int pn = hs >> 2, hh = hs & 3;
        f32x4 acc[4][4];
        wave_gemm64(acc,
            [&](int m, int r16) { return H1 + (size_t)(row0 + 16 * m + r16) * DM; },
            [&](int n, int r16) { const int d = 16 * n + r16; return WIN + (size_t)((pn << 8) + ((d >> 5) << 7) + (hh << 5) + (d & 31)) * DM; },
            DM, lane);
        const bool rope = (hs < 16) || (hs >= 24 && hs < 34);
        const float sc = (hs < 8 || (hs >= 24 && hs < 32)) ? QSCALE : 1.0f;
#pragma unroll
        for (int m = 0; m < 4; ++m) {
            const int t = row0 + 16 * m + r16l;
#pragma unroll
            for (int n = 0; n < 2; ++n) {
                const int d = 16 * n + 4 * q4;
                const f32x4 b1 = *(const f32x4*)(P.b_in + hs * 64 + d), b2 = *(const f32x4*)(P.b_in + hs * 64 + 32 + d);
                f32x4 v1 = acc[m][n] + b1, v2 = acc[m][n + 2] + b2, o1, o2;
                if (rope) { const f32x4 c = *(const f32x4*)(RC + (size_t)t * 32 + d), s = *(const f32x4*)(RS + (size_t)t * 32 + d);
                    o1 = v1 * c - v2 * s; o2 = v2 * c + v1 * s; }
                else { o1 = v1; o2 = v2; }
                o1 = o1 * sc; o2 = o2 * sc;
                bf16_t* dst = QKV + ((size_t)hs * NTOK + t) * 64 + d;
                u32x2 w1, w2; w1.x = pk2(o1.x, o1.y); w1.y = pk2(o1.z, o1.w); w2.x = pk2(o2.x, o2.y); w2.y = pk2(o2.z, o2.w);
                *(u32x2*)dst = w1; *(u32x2*)(dst + 32) = w2;
            }
        }
    }
}

__device__ __forceinline__ void p2_attn_naive(const Params& P, int gw, int ngw, int lane) {
    unsigned char* ws = P.ws;
    const bf16_t* QKV = (const bf16_t*)(ws + WS_QKV); bf16_t* PART = (bf16_t*)(ws + WS_PART); bf16_t* OSWA = (bf16_t*)(ws + WS_OSWA); float* LSE = (float*)(ws + WS_LSE);
    for (long it = gw; it < (long)NTOK * 32; it += ngw) {
        const int t = (int)(it >> 5), hc = (int)(it & 31);
        const int b = t / SEQ, s = t % SEQ;
        int r, nk, hq, hk, hv;
        if (hc < 24) { const int c = hc >> 3, h = hc & 7; r = (c == 0) ? 1 : (c == 1) ? 4 : 16; nk = 129; hq = h; hk = 8 + h; hv = 16 + h; }
        else { const int qh = hc - 24; r = 1; nk = 128; hq = 24 + qh; hk = 32 + (qh >> 2); hv = 34 + (qh >> 2); }
        const float q = bf2f(QKV[((size_t)hq * NTOK + t) * 64 + lane]);
        float m = -INFINITY, l = 0.f, o = 0.f;
        for (int dd = 0; dd < nk; ++dd) {
            const int sp = s - r * dd; if (sp < 0) break;
            const size_t tt = (size_t)b * SEQ + sp;
            const float kv = bf2f(QKV[((size_t)hk * NTOK + tt) * 64 + lane]);
            const float sc = wave_sum(q * kv);
            const float mn = fmaxf(m, sc), p = exp2f(sc - mn), al = exp2f(m - mn);
            const float vv = bf2f(QKV[((size_t)hv * NTOK + tt) * 64 + lane]);
            l = l * al + p; o = o * al + p * vv; m = mn;
        }
        if (hc < 24) { const int c = hc >> 3, h = hc & 7;
            PART[((size_t)c * NTOK + t) * 512 + h * 64 + lane] = (bf16_t)f2bf(o / l);
            if (lane == 0) LSE[((size_t)c * NTOK + t) * 8 + h] = m + log2f(l);
        } else { const int qh = hc - 24;
            const float den = l + exp2f(P.sinks[qh] * LOG2E - m);
            OSWA[(size_t)t * 512 + qh * 64 + lane] = (bf16_t)f2bf(o / den);
        }
    }
}

__device__ __forceinline__ void p2b_merge(const Params& P, int gw, int ngw, int lane) {
    unsigned char* ws = P.ws;
    const bf16_t* PART = (const bf16_t*)(ws + WS_PART); const bf16_t* OSWA = (const bf16_t*)(ws + WS_OSWA); const float* LSE = (const float*)(ws + WS_LSE);
    bf16_t* MIXED = (bf16_t*)(ws + WS_MIXED);
    for (int t = gw; t < NTOK; t += ngw) {
        const int h = lane >> 3;
        float ls[3], mx = -INFINITY;
#pragma unroll
        for (int c = 0; c < 3; ++c) { ls[c] = LSE[((size_t)c * NTOK + t) * 8 + h]; mx = fmaxf(mx, ls[c]); }
        float wsum = 0.f, w[3];
#pragma unroll
        for (int c = 0; c < 3; ++c) { w[c] = exp2f(ls[c] - mx); wsum += w[c]; }
        const float winv = 1.0f / wsum;
        float o[8];
#pragma unroll
        for (int i = 0; i < 8; ++i) o[i] = 0.f;
#pragma unroll
        for (int c = 0; c < 3; ++c) { const u32x4 pv = *(const u32x4*)(PART + ((size_t)c * NTOK + t) * 512 + lane * 8); const float wc = w[c] * winv;
            o[0] += wc * bflo(pv.x); o[1] += wc * bfhi(pv.x); o[2] += wc * bflo(pv.y); o[3] += wc * bfhi(pv.y);
            o[4] += wc * bflo(pv.z); o[5] += wc * bfhi(pv.z); o[6] += wc * bflo(pv.w); o[7] += wc * bfhi(pv.w); }
        float ss = 0.f;
#pragma unroll
        for (int i = 0; i < 8; ++i) ss += o[i] * o[i];
        float rstd = 1.0f / sqrtf(wave_sum(ss) * (1.0f / 512.0f) + EPS);
        { const f32x4 ga = *(const f32x4*)(P.gn_dil + lane * 8), gb = *(const f32x4*)(P.gn_dil + lane * 8 + 4);
          u32x4 w4; w4.x = pk2(o[0] * rstd * ga.x, o[1] * rstd * ga.y); w4.y = pk2(o[2] * rstd * ga.z, o[3] * rstd * ga.w);
          w4.z = pk2(o[4] * rstd * gb.x, o[5] * rstd * gb.y); w4.w = pk2(o[6] * rstd * gb.z, o[7] * rstd * gb.w);
          *(u32x4*)(MIXED + (size_t)t * DM + lane * 8) = w4; }
        { const u32x4 pv = *(const u32x4*)(OSWA + (size_t)t * 512 + lane * 8);
          o[0] = bflo(pv.x); o[1] = bfhi(pv.x); o[2] = bflo(pv.y); o[3] = bfhi(pv.y); o[4] = bflo(pv.z); o[5] = bfhi(pv.z); o[6] = bflo(pv.w); o[7] = bfhi(pv.w); }
        ss = 0.f;
#pragma unroll
        for (int i = 0; i < 8; ++i) ss += o[i] * o[i];
        rstd = 1.0f / sqrtf(wave_sum(ss) * (1.0f / 512.0f) + EPS);
        { const f32x4 ga = *(const f32x4*)(P.gn_swa + lane * 8), gb = *(const f32x4*)(P.gn_swa + lane * 8 + 4);
          u32x4 w4; w4.x = pk2(o[0] * rstd * ga.x, o[1] * rstd * ga.y); w4.y = pk2(o[2] * rstd * ga.z, o[3] * rstd * ga.w);
          w4.z = pk2(o[4] * rstd * gb.x, o[5] * rstd * gb.y); w4.w = pk2(o[6] * rstd * gb.z, o[7] * rstd * gb.w);
          *(u32x4*)(MIXED + (size_t)t * DM + 512 + lane * 8) = w4; }
    }
}

__device__ __forceinline__ void p3_outproj(const Params& P, int gw, int ngw, int lane) {
    unsigned char* ws = P.ws;
    const bf16_t* MIXED = (const bf16_t*)(ws + WS_MIXED); const bf16_t* WOUT = (const bf16_t*)(ws + WS_WOUT);
    const int q4 = lane >> 4, r16l = lane & 15;
    constexpr int NU = (NTOK / 64) * (DM / 64);
    for (int u = gw; u < NU; u += ngw) {
        const int ct = u % (DM / 64), rt = u / (DM / 64), row0 = rt * 64, col0 = ct * 64;
        f32x4 acc[4][4];
        wave_gemm64(acc,
            [&](int m, int r16) { return MIXED + (size_t)(row0 + 16 * m + r16) * DM; },
            [&](int n, int r16) { return WOUT + (size_t)(col0 + 16 * n + r16) * DM; },
            DM, lane);
#pragma unroll
        for (int m = 0; m < 4; ++m) { const size_t t = row0 + 16 * m + r16l;
#pragma unroll
            for (int n = 0; n < 4; ++n) { const int c = col0 + 16 * n + 4 * q4;
                const f32x4 xv = *(const f32x4*)(P.x + t * DM + c), bv = *(const f32x4*)(P.b_out + c);
                *(f32x4*)(P.out + t * DM + c) = xv + acc[m][n] + bv; } }
    }
}

__device__ __forceinline__ void p4_route(const Params& P, int gw, int ngw, int lane) {
    unsigned char* ws = P.ws;
    bf16_t* H2 = (bf16_t*)(ws + WS_H2); int* TOKL = (int*)(ws + WS_TOKL); int* ASSIGN = (int*)(ws + WS_ASSIGN); float* GATE = (float*)(ws + WS_GATE);
    unsigned* cnt = (unsigned*)(ws + WS_CTL) + CW_CNT;
    for (int t = gw; t < NTOK; t += ngw) {
        const f32x4* xr = (const f32x4*)(P.out + (size_t)t * DM) + lane; const f32x4* gr = (const f32x4*)P.g2 + lane;
        f32x4 v[4]; float ss = 0.f;
#pragma unroll
        for (int j = 0; j < 4; ++j) { v[j] = xr[64 * j]; ss += (v[j].x * v[j].x + v[j].y * v[j].y) + (v[j].z * v[j].z + v[j].w * v[j].w); }
        const float rstd = 1.0f / sqrtf(wave_sum(ss) * (1.0f / DM) + EPS);
        u32x2* o = (u32x2*)(H2 + (size_t)t * DM) + lane;
#pragma unroll
        for (int j = 0; j < 4; ++j) { const f32x4 g = gr[64 * j]; v[j] = v[j] * rstd * g; u32x2 w; w.x = pk2(v[j].x, v[j].y); w.y = pk2(v[j].z, v[j].w); o[64 * j] = w; }
        float lg[32];
#pragma unroll
        for (int e = 0; e < 32; ++e) lg[e] = 0.f;
#pragma unroll
        for (int j = 0; j < 4; ++j)
#pragma unroll
            for (int i = 0; i < 4; ++i) { const int k = 4 * (lane + 64 * j) + i; const float hv = v[j][i]; const f32x4* wr = (const f32x4*)(P.w_router + (size_t)k * 32);
#pragma unroll
                for (int e4 = 0; e4 < 8; ++e4) { const f32x4 w = wr[e4]; lg[4 * e4 + 0] += hv * w.x; lg[4 * e4 + 1] += hv * w.y; lg[4 * e4 + 2] += hv * w.z; lg[4 * e4 + 3] += hv * w.w; } }
#pragma unroll
        for (int e = 0; e < 32; ++e) lg[e] = wave_sum(lg[e]) + P.b_router[e];
        float val[4]; int idx[4];
#pragma unroll
        for (int k = 0; k < 4; ++k) { float best = -INFINITY; int bi = 0;
#pragma unroll
            for (int e = 0; e < 32; ++e) if (lg[e] > best) { best = lg[e]; bi = e; }
            val[k] = best; idx[k] = bi;
#pragma unroll
            for (int e = 0; e < 32; ++e) lg[e] = (e == bi) ? -INFINITY : lg[e]; }
        float ex[4], sum = 0.f;
#pragma unroll
        for (int k = 0; k < 4; ++k) { ex[k] = expf(val[k] - val[0]); sum += ex[k]; }
        if (lane < 4) {
            const int e = (lane == 0) ? idx[0] : (lane == 1) ? idx[1] : (lane == 2) ? idx[2] : idx[3];
            const float g = ((lane == 0) ? ex[0] : (lane == 1) ? ex[1] : (lane == 2) ? ex[2] : ex[3]) / sum;
            const unsigned pos = atomicAdd(cnt + e, 1u);
            TOKL[e * NTOK + pos] = t; ASSIGN[t * 4 + lane] = (e << 16) | (int)pos; GATE[t * 4 + lane] = g;
        }
    }
}

__device__ __forceinline__ void expert_tiles(const unsigned* cnt, int lane, int& my_cnt, int& my_tstart) {
    const int c = (int)__hip_atomic_load(cnt + (lane & 31), __ATOMIC_RELAXED, __HIP_MEMORY_SCOPE_AGENT);
    const int tl = (c + 255) >> 8; int inc = tl;
#pragma unroll
    for (int o = 1; o < 32; o <<= 1) { const int up = __shfl_up(inc, o, 32); if ((lane & 31) >= o) inc += up; }
    my_cnt = c; my_tstart = inc - tl;
}

__device__ __forceinline__ void p5_gemm1(const Params& P, int gw, int ngw, int lane) {
    unsigned char* ws = P.ws;
    const bf16_t* H2 = (const bf16_t*)(ws + WS_H2); const bf16_t* W1T = (const bf16_t*)(ws + WS_W1); bf16_t* HID = (bf16_t*)(ws + WS_HID);
    const int* TOKL = (const int*)(ws + WS_TOKL); const unsigned* cnt = (const unsigned*)(ws + WS_CTL) + CW_CNT;
    int mycnt, myts; expert_tiles(cnt, lane, mycnt, myts);
    const int q4 = lane >> 4, r16l = lane & 15;
    constexpr int RT = NTOK / 64, CT = DU / 64;
    for (int u = gw; u < NEXP * RT * CT; u += ngw) {
        const int e = u % NEXP, ct = (u / NEXP) % CT, rt = u / (NEXP * CT);
        const int ce = __shfl(mycnt, e), ts = __shfl(myts, e);
        if (rt * 64 >= ce) continue;
        f32x4 acc[4][4];
        wave_gemm64(acc,
            [&](int m, int r16) { int pos = rt * 64 + 16 * m + r16; pos = pos < ce ? pos : ce - 1; return H2 + (size_t)TOKL[e * NTOK + pos] * DM; },
            [&](int n, int r16) { return W1T + ((size_t)e * DU + ct * 64 + 16 * n + r16) * DM; },
            DM, lane);
#pragma unroll
        for (int m = 0; m < 4; ++m) { const int pos = rt * 64 + 16 * m + r16l;
#pragma unroll
            for (int n = 0; n < 4; ++n) { const int uc = ct * 64 + 16 * n + 4 * q4;
                const f32x4 bv = *(const f32x4*)(P.b1 + (size_t)e * DU + uc); const f32x4 v = acc[m][n] + bv;
                float hv[2];
#pragma unroll
                for (int p = 0; p < 2; ++p) { const float glu = fminf(v[2 * p], 7.0f), lin = fminf(fmaxf(v[2 * p + 1], -7.0f), 7.0f);
                    hv[p] = glu * (1.0f / (1.0f + __expf(-1.702f * glu))) * (lin + 1.0f); }
                if (pos < ce) *(unsigned*)(HID + ((size_t)ts * 256 + pos) * DFF + (uc >> 1)) = pk2(hv[0], hv[1]); } }
    }
}

__device__ __forceinline__ void p6_gemm2(const Params& P, int gw, int ngw, int lane) {
    unsigned char* ws = P.ws;
    const bf16_t* HID = (const bf16_t*)(ws + WS_HID); const bf16_t* W2T = (const bf16_t*)(ws + WS_W2); bf16_t* Y = (bf16_t*)(ws + WS_Y);
    const unsigned* cnt = (const unsigned*)(ws + WS_CTL) + CW_CNT;
    int mycnt, myts; expert_tiles(cnt, lane, mycnt, myts);
    const int q4 = lane >> 4, r16l = lane & 15;
    constexpr int RT = NTOK / 64, CT = DM / 64;
    for (int u = gw; u < NEXP * RT * CT; u += ngw) {
        const int e = u % NEXP, ct = (u / NEXP) % CT, rt = u / (NEXP * CT);
        const int ce = __shfl(mycnt, e), ts = __shfl(myts, e);
        if (rt * 64 >= ce) continue;
        f32x4 acc[4][4];
        wave_gemm64(acc,
            [&](int m, int r16) { return HID + ((size_t)ts * 256 + rt * 64 + 16 * m + r16) * DFF; },
            [&](int n, int r16) { return W2T + ((size_t)e * DM + ct * 64 + 16 * n + r16) * DFF; },
            DFF, lane);
#pragma unroll
        for (int m = 0; m < 4; ++m) { const int pos = rt * 64 + 16 * m + r16l;
#pragma unroll
            for (int n = 0; n < 4; ++n) { const int c = ct * 64 + 16 * n + 4 * q4;
                const f32x4 bv = *(const f32x4*)(P.b2 + (size_t)e * DM + c); const f32x4 v = acc[m][n] + bv;
                u32x2 w; w.x = pk2(v.x, v.y); w.y = pk2(v.z, v.w);
                if (pos < ce) *(u32x2*)(Y + ((size_t)ts * 256 + pos) * DM + c) = w; } }
    }
}

__device__ __forceinline__ void p7_combine(const Params& P, int gw, int ngw, int lane) {
    unsigned char* ws = P.ws;
    const bf16_t* Y = (const bf16_t*)(ws + WS_Y); const int* ASSIGN = (const int*)(ws + WS_ASSIGN); const float* GATE = (const float*)(ws + WS_GATE);
    const unsigned* cnt = (const unsigned*)(ws + WS_CTL) + CW_CNT;
    int mycnt, myts; expert_tiles(cnt, lane, mycnt, myts);
    for (int t = gw; t < NTOK; t += ngw) {
        f32x4* xr = (f32x4*)(P.out + (size_t)t * DM) + lane; const f32x4* gr = (const f32x4*)P.gf + lane;
        f32x4 v[4];
#pragma unroll
        for (int j = 0; j < 4; ++j) v[j] = xr[64 * j];
#pragma unroll
        for (int k = 0; k < 4; ++k) { const int a = ASSIGN[t * 4 + k]; const float g = GATE[t * 4 + k]; const int e = a >> 16, pos = a & 0xffff;
            const int ts = __shfl(myts, e);
            const u32x2* yr = (const u32x2*)(Y + ((size_t)ts * 256 + pos) * DM) + lane;
#pragma unroll
            for (int j = 0; j < 4; ++j) { const u32x2 w = yr[64 * j]; v[j].x += g * bflo(w.x); v[j].y += g * bfhi(w.x); v[j].z += g * bflo(w.y); v[j].w += g * bfhi(w.y); } }
        float ss = 0.f;
#pragma unroll
        for (int j = 0; j < 4; ++j) ss += (v[j].x * v[j].x + v[j].y * v[j].y) + (v[j].z * v[j].z + v[j].w * v[j].w);
        const float rstd = 1.0f / sqrtf(wave_sum(ss) * (1.0f / DM) + EPS);
#pragma unroll
        for (int j = 0; j < 4; ++j) xr[64 * j] = v[j] * rstd * gr[64 * j];
    }
}

#define GW_SETUP const int lane = threadIdx.x & 63; const int gw = blockIdx.x * (blockDim.x >> 6) + (threadIdx.x >> 6); const int ngw = gridDim.x * (blockDim.x >> 6);
__global__ void __launch_bounds__(256) k_p0(Params P) { extern __shared__ __attribute__((aligned(16))) unsigned char lds[]; GW_SETUP; p0_prologue(P, gw, ngw, lane, (LAS float*)lds + (threadIdx.x >> 6) * (64 * 33)); }
__global__ void __launch_bounds__(256) k_p1(Params P) { GW_SETUP; p1_qkv(P, gw, ngw, lane); }
__global__ void __launch_bounds__(256) k_p2(Params P) { GW_SETUP; p2_attn_naive(P, gw, ngw, lane); }
__global__ void __launch_bounds__(256) k_p2b(Params P) { GW_SETUP; p2b_merge(P, gw, ngw, lane); }
__global__ void __launch_bounds__(256) k_p3(Params P) { GW_SETUP; p3_outproj(P, gw, ngw, lane); }
__global__ void __launch_bounds__(256) k_p4(Params P) { GW_SETUP; p4_route(P, gw, ngw, lane); }
__global__ void __launch_bounds__(256) k_p5(Params P) { GW_SETUP; p5_gemm1(P, gw, ngw, lane); }
__global__ void __launch_bounds__(256) k_p6(Params P) { GW_SETUP; p6_gemm2(P, gw, ngw, lane); }
__global__ void __launch_bounds__(256) k_p7(Params P) { GW_SETUP; p7_combine(P, gw, ngw, lane); }

extern "C" void kernel_launch(void* const* d_in, const int* in_sizes, int n_in, void* d_out, int out_size, void* d_ws, size_t ws_size, hipStream_t stream) {
    if (n_in != 18 || out_size != NTOK * DM || ws_size < WS_END) { fprintf(stderr, "kernel_launch: unexpected shapes (n_in %d out %d ws %zu)\n", n_in, out_size, ws_size); return; }
    Params P{};
    P.x = (const float*)d_in[0]; P.pos = (const int*)d_in[1]; P.g1 = (const float*)d_in[2]; P.w_in = (const float*)d_in[3]; P.b_in = (const float*)d_in[4];
    P.sinks = (const float*)d_in[5]; P.gn_dil = (const float*)d_in[6]; P.gn_swa = (const float*)d_in[7]; P.w_out = (const float*)d_in[8]; P.b_out = (const float*)d_in[9];
    P.g2 = (const float*)d_in[10]; P.w_router = (const float*)d_in[11]; P.b_router = (const float*)d_in[12]; P.w1 = (const float*)d_in[13]; P.b1 = (const float*)d_in[14];
    P.w2 = (const float*)d_in[15]; P.b2 = (const float*)d_in[16]; P.gf = (const float*)d_in[17]; P.out = (float*)d_out; P.ws = (unsigned char*)d_ws;
    (void)hipMemsetAsync((char*)d_ws + WS_CTL, 0, CTL_BYTES, stream);
    const int G = 2048;
    hipLaunchKernelGGL(k_p0, dim3(G), dim3(256), 4 * 64 * 33 * 4, stream, P);
    hipLaunchKernelGGL(k_p1, dim3(G), dim3(256), 0, stream, P);
    hipLaunchKernelGGL(k_p2, dim3(4 * G), dim3(256), 0, stream, P);
    hipLaunchKernelGGL(k_p2b, dim3(G), dim3(256), 0, stream, P);
    hipLaunchKernelGGL(k_p3, dim3(G), dim3(256), 0, stream, P);
    hipLaunchKernelGGL(k_p4, dim3(G), dim3(256), 0, stream, P);
    hipLaunchKernelGGL(k_p5, dim3(G), dim3(256), 0, stream, P);
    hipLaunchKernelGGL(k_p6, dim3(G), dim3(256), 0, stream, P);
    hipLaunchKernelGGL(k_p7, dim3(G), dim3(256), 0, stream, P);
}
```

```cpp
#include <hip/hip_runtime.h>
#include <cstdio>
#include <cstdint>

#define LAS __attribute__((address_space(3)))
typedef unsigned short bf16_t;
typedef short bf16x8 __attribute__((ext_vector_type(8)));
typedef float f32x4 __attribute__((ext_vector_type(4)));
typedef unsigned u32x4 __attribute__((ext_vector_type(4)));
typedef unsigned u32x2 __attribute__((ext_vector_type(2)));

constexpr int BATCH = 8, SEQ = 4096, DM = 1024, NTOK = BATCH * SEQ;
constexpr int HD = 64, D_IN = 2304;
constexpr int NEXP = 32, DFF = 1024, DU = 2048;
constexpr float EPS = 1e-5f;
constexpr float LOG2E = 1.4426950408889634f;
constexpr float QSCALE = 0.125f * LOG2E;

constexpr size_t MiB = 1u << 20;
constexpr size_t WS_CTL = 0, CTL_BYTES = 1 * MiB;
constexpr size_t WS_WIN = 2 * MiB;
constexpr size_t WS_WRH = 7 * MiB;
constexpr size_t WS_WRL = 7 * MiB + 65536;
constexpr size_t WS_WOUT = 8 * MiB;
constexpr size_t WS_W1 = 16 * MiB;
constexpr size_t WS_W2 = 144 * MiB;
constexpr size_t WS_H1 = 208 * MiB;
constexpr size_t WS_QKV = 272 * MiB;
constexpr size_t WS_PART = 416 * MiB;
constexpr size_t WS_OSWA = 512 * MiB;
constexpr size_t WS_LSE = 544 * MiB;
constexpr size_t WS_MIXED = 548 * MiB;
constexpr size_t WS_H2 = 612 * MiB;
constexpr size_t WS_TOKL = 676 * MiB;
constexpr size_t WS_ASSIGN = 680 * MiB;
constexpr size_t WS_GATE = 680 * MiB + 512 * 1024;
constexpr size_t WS_HID = 682 * MiB;
constexpr size_t WS_ROPE = 954 * MiB;
constexpr size_t WS_RSL = 962 * MiB;
constexpr size_t WS_SR1 = 966 * MiB;
constexpr size_t WS_END = 967 * MiB;
constexpr size_t WS_X1B = 416 * MiB;
constexpr size_t WS_Y = 208 * MiB;
constexpr int CW_CNT = 1024;

struct Params {
    const float* x; const int* pos; const float* g1; const float* w_in; const float* b_in; const float* sinks;
    const float* gn_dil; const float* gn_swa; const float* w_out; const float* b_out; const float* g2;
    const float* w_router; const float* b_router; const float* w1; const float* b1; const float* w2; const float* b2; const float* gf;
    float* out; unsigned char* ws;
};

__device__ __forceinline__ unsigned f2bf(float f) { unsigned u = __builtin_bit_cast(unsigned, f); return (u + 0x7fffu + ((u >> 16) & 1u)) >> 16; }
__device__ __forceinline__ unsigned pk2(float lo, float hi) { return f2bf(lo) | (f2bf(hi) << 16); }
__device__ __forceinline__ float bf2f(unsigned h) { return __builtin_bit_cast(float, h << 16); }
__device__ __forceinline__ float bflo(unsigned w) { return __builtin_bit_cast(float, w << 16); }
__device__ __forceinline__ float bfhi(unsigned w) { return __builtin_bit_cast(float, w & 0xffff0000u); }
__device__ __forceinline__ unsigned pk4_fp8(float a, float b, float c, float d) { int w = 0; w = __builtin_amdgcn_cvt_pk_fp8_f32(a, b, w, false); w = __builtin_amdgcn_cvt_pk_fp8_f32(c, d, w, true); return (unsigned)w; }
constexpr float W_FP8_SCALE = 64.0f;
constexpr float HID_FP8_SCALE = 4.0f;
constexpr float H2_FP8_SCALE = 16.0f;
constexpr float MIX_FP8_SCALE = 16.0f;
constexpr float Y_FP8_SCALE = 16.0f;
__device__ __forceinline__ float wave_sum(float v) {
#pragma unroll
    for (int o = 1; o < 64; o <<= 1) v += __shfl_xor(v, o);
    return v;
}
__host__ __device__ __forceinline__ int qkv_phys32(int n0) { const int pn = n0 >> 8, w = n0 & 255, hh = w >> 6, bj = (w >> 5) & 1; return (pn << 8) + (bj << 7) + (hh << 5); }

template <bool FP8>
__device__ __forceinline__ void transpose_item(const float* W, int K, int N, void* WTv, bool perm, LAS float* scr, int item, int lane) {
    const int nblk = N / 32, kb = item / nblk, nb = item % nblk, k0 = 64 * kb, n0 = 32 * nb;
    const int lr = lane >> 3, lc = (lane & 7) * 4;
    f32x4 v[8];
#pragma unroll
    for (int i = 0; i < 8; ++i) v[i] = __builtin_nontemporal_load((const f32x4*)(W + (size_t)(k0 + 8 * i + lr) * N + n0 + lc));
#pragma unroll
    for (int i = 0; i < 8; ++i) *(LAS f32x4*)(scr + (8 * i + lr) * 36 + (lc ^ (i << 2))) = v[i];
    asm volatile("s_waitcnt lgkmcnt(0)" ::: "memory");
    const int c = lane & 7;
    const int ob = perm ? qkv_phys32(n0) : n0;
#pragma unroll
    for (int j = 0; j < 4; ++j) { const int n = (lane >> 3) + 8 * j; const LAS float* s = scr + (8 * c) * 36 + (n ^ (c << 2));
        if constexpr (FP8) { u32x2 o; o.x = pk4_fp8(s[0 * 36] * W_FP8_SCALE, s[1 * 36] * W_FP8_SCALE, s[2 * 36] * W_FP8_SCALE, s[3 * 36] * W_FP8_SCALE);
            o.y = pk4_fp8(s[4 * 36] * W_FP8_SCALE, s[5 * 36] * W_FP8_SCALE, s[6 * 36] * W_FP8_SCALE, s[7 * 36] * W_FP8_SCALE);
            __builtin_nontemporal_store(o, (u32x2*)((unsigned char*)WTv + (size_t)(ob + n) * K + k0 + 8 * c)); }
        else { u32x4 o; o.x = pk2(s[0 * 36], s[1 * 36]); o.y = pk2(s[2 * 36], s[3 * 36]); o.z = pk2(s[4 * 36], s[5 * 36]); o.w = pk2(s[6 * 36], s[7 * 36]);
            *(u32x4*)((bf16_t*)WTv + (size_t)(ob + n) * K + k0 + 8 * c) = o; } }
    asm volatile("s_waitcnt lgkmcnt(0)" ::: "memory");
}

constexpr int TI_IN = (DM / 64) * (D_IN / 32), TI_OUT = (DM / 64) * (DM / 32), TI_1 = (DM / 64) * (DU / 32), TI_2 = (DFF / 64) * (DM / 32);
constexpr int TI_ALL = TI_IN + TI_OUT + NEXP * (TI_1 + TI_2);
__device__ __forceinline__ void weight_items(const Params& P, int first, int last, int w, int nw, int lane, LAS float* scr) {
    unsigned char* ws = P.ws;
    bf16_t* WIN = (bf16_t*)(ws + WS_WIN); bf16_t* WOUT = (bf16_t*)(ws + WS_WOUT); bf16_t* W1T = (bf16_t*)(ws + WS_W1); bf16_t* W2T = (bf16_t*)(ws + WS_W2);
    for (int it = first + w; it < last; it += nw) {
        int r = it;
        if (r < TI_IN) { transpose_item<false>(P.w_in, DM, D_IN, WIN, true, scr, r, lane); continue; } r -= TI_IN;
        if (r < TI_OUT) { transpose_item<true>(P.w_out, DM, DM, WOUT, false, scr, r, lane); continue; } r -= TI_OUT;
        if (r < NEXP * TI_1) { const int e = r / TI_1; transpose_item<true>(P.w1 + (size_t)e * DM * DU, DM, DU, (unsigned char*)W1T + (size_t)e * DU * DM, false, scr, r % TI_1, lane); continue; } r -= NEXP * TI_1;
        { const int e = r / TI_2; transpose_item<true>(P.w2 + (size_t)e * DFF * DM, DFF, DM, (unsigned char*)W2T + (size_t)e * DM * DFF, false, scr, r % TI_2, lane); }
    }
}
__device__ __forceinline__ void p0_prologue(const Params& P, int gw, int ngw, int lane, LAS float* scr, int n_items) {
    unsigned char* ws = P.ws;
    weight_items(P, 0, n_items, gw, ngw, lane, scr);
    bf16_t* H1 = (bf16_t*)(ws + WS_H1); float* SR1 = (float*)(ws + WS_SR1);
    { f32x4 g[4];
#pragma unroll
      for (int j = 0; j < 4; ++j) g[j] = ((const f32x4*)P.g1 + lane)[64 * j];
      for (int t0 = 4 * gw; t0 < NTOK; t0 += 4 * ngw) {
        f32x4 v[4][4];
#pragma unroll
        for (int q = 0; q < 4; ++q) { const f32x4* xr = (const f32x4*)(P.x + (size_t)(t0 + q) * DM) + lane;
#pragma unroll
            for (int j = 0; j < 4; ++j) v[q][j] = __builtin_nontemporal_load(xr + 64 * j); }
#pragma unroll
        for (int q = 0; q < 4; ++q) { float ss = 0.f;
#pragma unroll
            for (int j = 0; j < 4; ++j) ss += (v[q][j].x * v[q][j].x + v[q][j].y * v[q][j].y) + (v[q][j].z * v[q][j].z + v[q][j].w * v[q][j].w);
            const float sd = sqrtf(wave_sum(ss) * (1.0f / DM) + EPS), rstd = 1.0f / sd;
            if (lane == 0) SR1[t0 + q] = sd;
            u32x2* o = (u32x2*)(H1 + (size_t)(t0 + q) * DM) + lane;
#pragma unroll
            for (int j = 0; j < 4; ++j) { u32x2 w; w.x = pk2(v[q][j].x * rstd * g[j].x, v[q][j].y * rstd * g[j].y); w.y = pk2(v[q][j].z * rstd * g[j].z, v[q][j].w * rstd * g[j].w); o[64 * j] = w; } }
      } }
    { bf16_t* WRH = (bf16_t*)(ws + WS_WRH); bf16_t* WRL = (bf16_t*)(ws + WS_WRL);
      for (int idx = gw * 64 + lane; idx < NEXP * DM; idx += ngw * 64) { const int e = idx >> 10, k = idx & 1023;
          const float w = P.w_router[k * NEXP + e]; const unsigned h = f2bf(w); WRH[idx] = (bf16_t)h; WRL[idx] = (bf16_t)f2bf(w - bf2f(h)); } }
    float* RC = (float*)(ws + WS_ROPE); float* RS = RC + (size_t)NTOK * 32;
    for (int idx = gw * 64 + lane; idx < NTOK * 32; idx += ngw * 64) {
        const int t = idx >> 5, i = idx & 31;
        const float inv = (float)exp2(-(double)i * (13.287712379549449 / 32.0));
        const float ang = (float)P.pos[t] * inv;
        const double a = (double)ang * 0.15915494309189535;
        const float fr = (float)(a - rint(a));
        RC[idx] = __builtin_amdgcn_cosf(fr); RS[idx] = __builtin_amdgcn_sinf(fr);
    }
}

namespace att {
typedef float f32x16 __attribute__((ext_vector_type(16)));
typedef short s16x4 __attribute__((ext_vector_type(4)));
constexpr int OOFF = 98304;
constexpr int KOFF = 0, VOFF = 49152;
constexpr float THR = 8.0f;
__device__ __forceinline__ int crow(int r, int hi) { return (r & 3) + 8 * (r >> 2) + 4 * hi; }
__device__ __forceinline__ s16x4 vtr(const LAS unsigned char* p) { return __builtin_bit_cast(s16x4, __builtin_amdgcn_ds_read_tr16_b64_v4i16((LAS s16x4*)p)); }
__device__ __forceinline__ void xswap(float v, float& a, float& b) { const unsigned u = __builtin_bit_cast(unsigned, v); auto rr = __builtin_amdgcn_permlane32_swap(u, u, false, false); const unsigned r0 = rr[0], r1 = rr[1]; a = __builtin_bit_cast(float, r0); b = __builtin_bit_cast(float, r1); }
__device__ __forceinline__ float xmax(float v) { float a, b; xswap(v, a, b); return fmaxf(a, b); }
__device__ __forceinline__ float xsum(float v) { float a, b; xswap(v, a, b); return a + b; }
__device__ __forceinline__ unsigned cvtpk(float lo, float hi) { unsigned r; asm("v_cvt_pk_bf16_f32 %0, %1, %2" : "=v"(r) : "v"(lo), "v"(hi)); return r; }

struct UnitInfo { int kind, h, r, nb, dm; size_t tok0; const bf16_t* qb; const bf16_t* kb; const bf16_t* vb; };
__device__ __forceinline__ UnitInfo decode(const Params& P, int unit) {
    UnitInfo u; const bf16_t* QKV = (const bf16_t*)(P.ws + WS_QKV);
    const int kind = unit >> 10, within = unit & 1023, b = within >> 7, h = (within >> 4) & 7, sub = within & 15;
    int r, c, nb, hq, hk, hv;
    if (kind == 0) { r = 1; c = 0; nb = sub; } else if (kind == 1) { r = 4; c = sub >> 2; nb = sub & 3; } else if (kind == 2) { r = 16; c = sub; nb = 0; } else { r = 1; c = 0; nb = sub; }
    if (kind < 3) { hq = h; hk = 8 + h; hv = 16 + h; u.dm = 0; } else { hq = 24 + h; hk = 32 + (h >> 2); hv = 34 + (h >> 2); u.dm = 1; }
    u.kind = kind; u.h = h; u.r = r; u.nb = nb; u.tok0 = (size_t)b * SEQ + c;
    u.qb = QKV + ((size_t)hq * NTOK + u.tok0) * 64; u.kb = QKV + ((size_t)hk * NTOK + u.tok0) * 64; u.vb = QKV + ((size_t)hv * NTOK + u.tok0) * 64;
    return u;
}
__device__ __forceinline__ void unit_loads(const UnitInfo& u, int tid, int lane, int wave, u32x4 (&kv)[6], u32x4 (&vv)[6], bf16x8 (&q)[4]) {
    const int c8 = tid & 7, j0 = tid >> 3, kbase = 256 * u.nb - 128;
#pragma unroll
    for (int i = 0; i < 6; ++i) { if (u.nb > 0 || i >= 2) { const long l = kbase + j0 + 64 * i; kv[i] = *(const u32x4*)(u.kb + l * u.r * 64 + c8 * 8); vv[i] = *(const u32x4*)(u.vb + l * u.r * 64 + c8 * 8); } }
    const bf16_t* qp = u.qb + (size_t)(256 * u.nb + 32 * wave + (lane & 31)) * u.r * 64 + 8 * (lane >> 5);
#pragma unroll
    for (int d0 = 0; d0 < 4; ++d0) q[d0] = *(const bf16x8*)(qp + 16 * d0);
}
__device__ __forceinline__ void unit_fill(LAS unsigned char* lds, int nb, int tid, const u32x4 (&kv)[6], const u32x4 (&vv)[6]) {
    const int c8 = tid & 7, j0 = tid >> 3, key = j0 & 31;
    LAS unsigned char* kd = lds + KOFF + (j0 >> 5) * 4096 + key * 128 + ((c8 ^ ((key >> 1) & 7)) << 4);
    LAS unsigned char* vd = lds + VOFF + (c8 >> 2) * 4096 + j0 * 64 + (c8 & 3) * 16;
#pragma unroll
    for (int i = 0; i < 6; ++i) { if (nb > 0 || i >= 2) { *(LAS u32x4*)(kd + i * 8192) = kv[i]; *(LAS u32x4*)(vd + i * 8192) = vv[i]; } }
}
__device__ __forceinline__ void unit_compute(const Params& P, LAS unsigned char* lds, const UnitInfo& u, const bf16x8 (&qr)[4], int lane, int wave) {
    const int r32 = lane & 31, hi = lane >> 5, nb = u.nb;
    float mref = -INFINITY, l = 0.f; f32x16 o[2];
#pragma unroll
    for (int x = 0; x < 16; ++x) { o[0][x] = 0.f; o[1][x] = 0.f; }
    const int vlane = ((lane >> 4) & 1) * 32 + (lane & 3) * 8 + (4 * hi + ((lane & 15) >> 2)) * 64;
#pragma unroll
    for (int jt = 4; jt >= 0; --jt) {
        const int kt = wave + jt;
        if (nb == 0 && kt < 4) break;
        const LAS unsigned char* kb = lds + KOFF + kt * 4096 + r32 * 128;
        f32x16 p;
#pragma unroll
        for (int x = 0; x < 16; ++x) p[x] = 0.f;
#pragma unroll
        for (int d0 = 0; d0 < 4; ++d0) { const bf16x8 kf = *(const LAS bf16x8*)(kb + (((2 * d0 + hi) ^ ((r32 >> 1) & 7)) << 4)); p = __builtin_amdgcn_mfma_f32_32x32x16_bf16(kf, qr[d0], p, 0, 0, 0); }
        if (jt == 4) {
#pragma unroll
            for (int x = 0; x < 16; ++x) if (crow(x, hi) > r32) p[x] = -INFINITY;
        }
        if (jt == 0) {
#pragma unroll
            for (int x = 0; x < 16; ++x) if (crow(x, hi) < r32 + u.dm) p[x] = -INFINITY;
        }
        float tm = fmaxf(fmaxf(p[0], p[1]), p[2]);
#pragma unroll
        for (int x = 3; x < 15; x += 2) tm = fmaxf(fmaxf(tm, p[x]), p[x + 1]);
        tm = xmax(fmaxf(tm, p[15]));
        const float mn = fmaxf(mref, tm), al = __builtin_amdgcn_exp2f(mref - mn);
        mref = mn;
        float ls = 0.f;
#pragma unroll
        for (int x = 0; x < 16; ++x) { p[x] = __builtin_amdgcn_exp2f(p[x] - mn); ls += p[x]; }
        l = l * al + ls;
#pragma unroll
        for (int x = 0; x < 16; ++x) { o[0][x] *= al; o[1][x] *= al; }
        u32x4 pw[2];
#pragma unroll
        for (int s2 = 0; s2 < 2; ++s2) { pw[s2].x = cvtpk(p[8 * s2 + 0], p[8 * s2 + 1]); pw[s2].y = cvtpk(p[8 * s2 + 2], p[8 * s2 + 3]); pw[s2].z = cvtpk(p[8 * s2 + 4], p[8 * s2 + 5]); pw[s2].w = cvtpk(p[8 * s2 + 6], p[8 * s2 + 7]); }
        const LAS unsigned char* vb = lds + VOFF + (kt >> 1) * 8192 + (kt & 1) * 2048 + vlane;
#pragma unroll
        for (int d0 = 0; d0 < 2; ++d0)
#pragma unroll
            for (int s2 = 0; s2 < 2; ++s2) { const s16x4 lo = vtr(vb + d0 * 4096 + s2 * 1024), hh = vtr(vb + d0 * 4096 + s2 * 1024 + 512);
                const bf16x8 vf = (bf16x8){lo[0], lo[1], lo[2], lo[3], hh[0], hh[1], hh[2], hh[3]};
                o[d0] = __builtin_amdgcn_mfma_f32_32x32x16_bf16(vf, __builtin_bit_cast(bf16x8, pw[s2]), o[d0], 0, 0, 0); }
    }
    l = xsum(l);
    const size_t t = u.tok0 + (size_t)(256 * nb + 32 * wave + r32) * u.r;
    float inv; bf16_t* dst; size_t pitch;
    if (u.kind < 3) { inv = 1.0f / l; dst = (bf16_t*)(P.ws + WS_PART) + ((size_t)u.kind * NTOK + u.tok0 + (size_t)(256 * nb + 32 * wave) * u.r) * 512 + u.h * 64;
        if (hi == 0) ((float*)(P.ws + WS_LSE))[((size_t)u.kind * NTOK + t) * 8 + u.h] = mref + __builtin_amdgcn_logf(l); }
    else { inv = 1.0f / (l + __builtin_amdgcn_exp2f(P.sinks[u.h] * LOG2E - mref)); dst = (bf16_t*)(P.ws + WS_OSWA) + (u.tok0 + (size_t)(256 * nb + 32 * wave) * u.r) * 512 + u.h * 64; }
    pitch = (size_t)u.r * 512;
    LAS unsigned char* stg = lds + OOFF + wave * 4096;
#pragma unroll
    for (int d0 = 0; d0 < 2; ++d0)
#pragma unroll
        for (int g = 0; g < 4; ++g) { u32x2 w; w.x = cvtpk(o[d0][4 * g] * inv, o[d0][4 * g + 1] * inv); w.y = cvtpk(o[d0][4 * g + 2] * inv, o[d0][4 * g + 3] * inv);
            *(LAS u32x2*)(stg + r32 * 128 + (((4 * d0 + g) ^ (r32 & 7)) << 4) + 8 * hi) = w; }
#pragma unroll
    for (int i = 0; i < 4; ++i) { const int row = 8 * i + (lane >> 3), ch = lane & 7;
        const u32x4 v = *(const LAS u32x4*)(stg + row * 128 + ((ch ^ (row & 7)) << 4));
        *(u32x4*)(dst + (size_t)row * pitch + 8 * ch) = v; }
}
__device__ __forceinline__ int unit_of(int it, int wg, int G) {
    if (G != 256) return it * G + wg;
    const int x = wg & 7, y = wg >> 3;
    const int gl = 2 * it + (y >> 4), sub = y & 15;
    int kind, b, h;
    if (gl < 24) { kind = gl >> 3; b = gl & 7; h = x; } else { const int q = gl - 24; kind = 3; b = 4 * (q >> 2 & 1) + (x >> 1); h = 4 * (x & 1) + (q & 3); }
    return (kind << 10) | (b << 7) | (h << 4) | sub;
}
__device__ __forceinline__ void attn_phase(const Params& P, LAS unsigned char* lds, int tid, int lane, int wave) {
    const int G = gridDim.x, nit = (4096 + G - 1) / G; int it = 0;
    int unit = unit_of(0, blockIdx.x, G); if (unit >= 4096) return;
    UnitInfo cur = decode(P, unit);
    u32x4 kv[6], vv[6]; bf16x8 qn[4];
    unit_loads(cur, tid, lane, wave, kv, vv, qn);
    for (;;) {
        unit_fill(lds, cur.nb, tid, kv, vv);
        bf16x8 qr[4];
#pragma unroll
        for (int d0 = 0; d0 < 4; ++d0) qr[d0] = qn[d0];
        __syncthreads();
        const int nunit = (it + 1 < nit) ? unit_of(it + 1, blockIdx.x, G) : 4096; const bool has_next = nunit < 4096;
        UnitInfo nxt = cur;
        if (has_next) { nxt = decode(P, nunit); unit_loads(nxt, tid, lane, wave, kv, vv, qn); }
        unit_compute(P, lds, cur, qr, lane, wave);
        __syncthreads();
        if (!has_next) break;
        cur = nxt; unit = nunit; ++it;
    }
}
}

__device__ __forceinline__ void p2b_merge(const Params& P, int gw, int ngw, int lane) {
    unsigned char* ws = P.ws;
    const bf16_t* PART = (const bf16_t*)(ws + WS_PART); const bf16_t* OSWA = (const bf16_t*)(ws + WS_OSWA); const float* LSE = (const float*)(ws + WS_LSE);
    unsigned char* MIXED = ws + WS_MIXED;
    const f32x4 gda = *(const f32x4*)(P.gn_dil + lane * 8), gdb = *(const f32x4*)(P.gn_dil + lane * 8 + 4), gsa = *(const f32x4*)(P.gn_swa + lane * 8), gsb = *(const f32x4*)(P.gn_swa + lane * 8 + 4);
    const int h = lane >> 3;
    for (int t0 = 4 * gw; t0 < NTOK; t0 += 4 * ngw) {
        float ls[4][3]; u32x4 pv[4][3], sv[4];
#pragma unroll
        for (int q = 0; q < 4; ++q) { const int t = t0 + q;
#pragma unroll
            for (int c = 0; c < 3; ++c) { ls[q][c] = LSE[((size_t)c * NTOK + t) * 8 + h]; pv[q][c] = *(const u32x4*)(PART + ((size_t)c * NTOK + t) * 512 + lane * 8); }
            sv[q] = *(const u32x4*)(OSWA + (size_t)t * 512 + lane * 8); }
#pragma unroll
        for (int q = 0; q < 4; ++q) { const int t = t0 + q;
            const float mx = fmaxf(fmaxf(ls[q][0], ls[q][1]), ls[q][2]);
            float wsum = 0.f, w[3];
#pragma unroll
            for (int c = 0; c < 3; ++c) { w[c] = exp2f(ls[q][c] - mx); wsum += w[c]; }
            const float winv = 1.0f / wsum;
            float o[8];
#pragma unroll
            for (int i = 0; i < 8; ++i) o[i] = 0.f;
#pragma unroll
            for (int c = 0; c < 3; ++c) { const u32x4 v = pv[q][c]; const float wc = w[c] * winv;
                o[0] += wc * bflo(v.x); o[1] += wc * bfhi(v.x); o[2] += wc * bflo(v.y); o[3] += wc * bfhi(v.y);
                o[4] += wc * bflo(v.z); o[5] += wc * bfhi(v.z); o[6] += wc * bflo(v.w); o[7] += wc * bfhi(v.w); }
            float ss = 0.f;
#pragma unroll
            for (int i = 0; i < 8; ++i) ss += o[i] * o[i];
            float rstd = MIX_FP8_SCALE / sqrtf(wave_sum(ss) * (1.0f / 512.0f) + EPS);
            { u32x2 w2; w2.x = pk4_fp8(o[0] * rstd * gda.x, o[1] * rstd * gda.y, o[2] * rstd * gda.z, o[3] * rstd * gda.w);
              w2.y = pk4_fp8(o[4] * rstd * gdb.x, o[5] * rstd * gdb.y, o[6] * rstd * gdb.z, o[7] * rstd * gdb.w);
              *(u32x2*)(MIXED + (size_t)t * DM + lane * 8) = w2; }
            { const u32x4 v = sv[q];
              o[0] = bflo(v.x); o[1] = bfhi(v.x); o[2] = bflo(v.y); o[3] = bfhi(v.y); o[4] = bflo(v.z); o[5] = bfhi(v.z); o[6] = bflo(v.w); o[7] = bfhi(v.w); }
            ss = 0.f;
#pragma unroll
            for (int i = 0; i < 8; ++i) ss += o[i] * o[i];
            rstd = MIX_FP8_SCALE / sqrtf(wave_sum(ss) * (1.0f / 512.0f) + EPS);
            { u32x2 w2; w2.x = pk4_fp8(o[0] * rstd * gsa.x, o[1] * rstd * gsa.y, o[2] * rstd * gsa.z, o[3] * rstd * gsa.w);
              w2.y = pk4_fp8(o[4] * rstd * gsb.x, o[5] * rstd * gsb.y, o[6] * rstd * gsb.z, o[7] * rstd * gsb.w);
              *(u32x2*)(MIXED + (size_t)t * DM + 512 + lane * 8) = w2; }
        }
    }
}

namespace route {
constexpr int NWAVES_R = 8;
constexpr int R_W = 0;
constexpr int R_LCNT = 131072 + 1024;
constexpr int R_REC = R_LCNT + 256;
constexpr int R_G2 = 131072 + 10240;
constexpr int XPRE = 24;
__device__ __forceinline__ void merge4(float (&v)[4], int (&e)[4], const float (&pv)[4], const int (&pe)[4]) {
    float cv[8]; int ce[8];
#pragma unroll
    for (int k = 0; k < 4; ++k) { cv[k] = v[k]; ce[k] = e[k]; cv[4 + k] = pv[k]; ce[4 + k] = pe[k]; }
#pragma unroll
    for (int k = 0; k < 4; ++k) { float best = -INFINITY; int bi = 0, be = 0;
#pragma unroll
        for (int x = 0; x < 8; ++x) { const bool better = (cv[x] > best) || (cv[x] == best && ce[x] < be); if (better) { best = cv[x]; bi = x; be = ce[x]; } }
        v[k] = best; e[k] = be;
#pragma unroll
        for (int x = 0; x < 8; ++x) cv[x] = (x == bi) ? -INFINITY : cv[x]; }
}
typedef float rf32x2 __attribute__((ext_vector_type(2)));
typedef __bf16 rbf16x2 __attribute__((ext_vector_type(2)));
__device__ __forceinline__ unsigned cvtpk(float lo, float hi) { const rf32x2 v = {lo, hi}; return __builtin_bit_cast(unsigned, __builtin_convertvector(v, rbf16x2)); }
__device__ __forceinline__ void stage_weights(const Params& P, LAS unsigned char* lds, int tid) {
    const u32x4* src = (const u32x4*)(P.ws + WS_WRH);
#pragma unroll 4
    for (int i = tid; i < 8192; i += NWAVES_R * 64) { const int half = i >> 12, e = (i >> 7) & 31, ch = i & 127;
        *(LAS u32x4*)(lds + R_W + half * 65536 + e * 2048 + ((ch ^ (e & 15)) << 4)) = src[i]; }
    if (tid < 256) *(LAS f32x4*)(lds + R_G2 + tid * 16) = *(const f32x4*)(P.g2 + tid * 4);
}
__device__ __forceinline__ void route_block(const Params& P, LAS unsigned char* lds, int tb, int tid, int lane, int wave, bool stage) {
    unsigned char* ws = P.ws;
    bf16_t* H2 = (bf16_t*)(ws + WS_H2);
    const int tk = lane & 15, fq = lane >> 4;
    const int t = tb * 128 + wave * 16 + tk;
    LAS unsigned* lcnt = (LAS unsigned*)(lds + R_LCNT);
    const bf16_t* xp = (const bf16_t*)(ws + WS_X1B) + (size_t)t * DM + 8 * fq;
    if (stage) stage_weights(P, lds, tid);
    u32x4 xwv[32];
#pragma unroll
    for (int ks = 0; ks < XPRE; ++ks) xwv[ks] = *(const u32x4*)(xp + 32 * ks);
    if (tid < 64) lcnt[tid] = 0u;
    asm volatile("s_waitcnt vmcnt(0) lgkmcnt(0)" ::: "memory");
    __builtin_amdgcn_s_barrier();
    const LAS float* gp = (const LAS float*)(lds + R_G2) + 8 * fq;
    const LAS unsigned char* wrow = lds + R_W + tk * 2048;
    unsigned char* hp = (unsigned char*)H2 + (size_t)t * DM + 8 * fq;
    f32x4 d0 = {0.f, 0.f, 0.f, 0.f}, d1 = {0.f, 0.f, 0.f, 0.f};
    float ss = 0.f;
#pragma unroll
    for (int ks = 0; ks < 32; ++ks) {
        if (ks == 32 - XPRE) {
#pragma unroll
            for (int k2 = XPRE; k2 < 32; ++k2) xwv[k2] = *(const u32x4*)(xp + 32 * k2); }
        const u32x4 xw = xwv[ks]; const f32x4 xa = {bflo(xw.x), bfhi(xw.x), bflo(xw.y), bfhi(xw.y)}, xb = {bflo(xw.z), bfhi(xw.z), bflo(xw.w), bfhi(xw.w)}, ga = *(const LAS f32x4*)(gp + 32 * ks), gb = *(const LAS f32x4*)(gp + 32 * ks + 4);
        const int wo = ((4 * ks + fq) ^ tk) << 4;
        const bf16x8 ah0 = *(const LAS bf16x8*)(wrow + wo), al0 = *(const LAS bf16x8*)(wrow + 65536 + wo), ah1 = *(const LAS bf16x8*)(wrow + 32768 + wo), al1 = *(const LAS bf16x8*)(wrow + 98304 + wo);
        ss += (xa.x * xa.x + xa.y * xa.y) + (xa.z * xa.z + xa.w * xa.w) + (xb.x * xb.x + xb.y * xb.y) + (xb.z * xb.z + xb.w * xb.w);
        const f32x4 ha = xa * ga, hb = xb * gb;
        u32x4 bh, bl;
        bh.x = cvtpk(ha[0], ha[1]); bh.y = cvtpk(ha[2], ha[3]); bh.z = cvtpk(hb[0], hb[1]); bh.w = cvtpk(hb[2], hb[3]);
        bl.x = cvtpk(ha[0] - bflo(bh.x), ha[1] - bfhi(bh.x)); bl.y = cvtpk(ha[2] - bflo(bh.y), ha[3] - bfhi(bh.y)); bl.z = cvtpk(hb[0] - bflo(bh.z), hb[1] - bfhi(bh.z)); bl.w = cvtpk(hb[2] - bflo(bh.w), hb[3] - bfhi(bh.w));
        { u32x2 h8; h8.x = pk4_fp8(ha[0] * H2_FP8_SCALE, ha[1] * H2_FP8_SCALE, ha[2] * H2_FP8_SCALE, ha[3] * H2_FP8_SCALE); h8.y = pk4_fp8(hb[0] * H2_FP8_SCALE, hb[1] * H2_FP8_SCALE, hb[2] * H2_FP8_SCALE, hb[3] * H2_FP8_SCALE); *(u32x2*)(hp + 32 * ks) = h8; }
        const bf16x8 bhv = __builtin_bit_cast(bf16x8, bh), blv = __builtin_bit_cast(bf16x8, bl);
        d0 = __builtin_amdgcn_mfma_f32_16x16x32_bf16(ah0, bhv, d0, 0, 0, 0); d1 = __builtin_amdgcn_mfma_f32_16x16x32_bf16(ah1, bhv, d1, 0, 0, 0);
        d0 = __builtin_amdgcn_mfma_f32_16x16x32_bf16(al0, bhv, d0, 0, 0, 0); d1 = __builtin_amdgcn_mfma_f32_16x16x32_bf16(al1, bhv, d1, 0, 0, 0);
        d0 = __builtin_amdgcn_mfma_f32_16x16x32_bf16(ah0, blv, d0, 0, 0, 0); d1 = __builtin_amdgcn_mfma_f32_16x16x32_bf16(ah1, blv, d1, 0, 0, 0);
    }
    ss += __shfl_xor(ss, 16); ss += __shfl_xor(ss, 32);
    const float rstd = 1.0f / sqrtf(ss * (1.0f / DM) + EPS);
    float v[8]; int ve[8];
#pragma unroll
    for (int i = 0; i < 4; ++i) { ve[i] = 4 * fq + i; ve[4 + i] = 16 + 4 * fq + i; v[i] = d0[i] * rstd + P.b_router[ve[i]]; v[4 + i] = d1[i] * rstd + P.b_router[ve[4 + i]]; }
    float tv[4]; int te[4];
#pragma unroll
    for (int k = 0; k < 4; ++k) { float best = -INFINITY; int bi = 0;
#pragma unroll
        for (int x = 0; x < 8; ++x) if (v[x] > best) { best = v[x]; bi = x; }
        tv[k] = best; te[k] = (bi < 4) ? (4 * fq + bi) : (12 + 4 * fq + bi);
#pragma unroll
        for (int x = 0; x < 8; ++x) v[x] = (x == bi) ? -INFINITY : v[x]; }
#pragma unroll
    for (int rnd = 0; rnd < 2; ++rnd) { float pv[4]; int pe[4];
#pragma unroll
        for (int k = 0; k < 4; ++k) { pv[k] = __shfl_xor(tv[k], 16 << rnd); pe[k] = __shfl_xor(te[k], 16 << rnd); }
        merge4(tv, te, pv, pe); }
    float gate[4], sum = 0.f;
#pragma unroll
    for (int k = 0; k < 4; ++k) { gate[k] = __expf(tv[k] - tv[0]); sum += gate[k]; }
    const float rs = 1.0f / sum;
    if (fq == 0) {
#pragma unroll
        for (int k = 0; k < 4; ++k) { const unsigned rank = __hip_atomic_fetch_add(&lcnt[te[k]], 1u, __ATOMIC_RELAXED, __HIP_MEMORY_SCOPE_WORKGROUP);
            *(LAS u32x4*)(lds + R_REC + ((wave * 16 + tk) * 4 + k) * 16) = (u32x4){(unsigned)te[k], rank, __builtin_bit_cast(unsigned, gate[k] * rs), __builtin_bit_cast(unsigned, rstd)}; } }
    __syncthreads();
    if (tid < 32) { unsigned* cnt = (unsigned*)(ws + WS_CTL) + CW_CNT; const unsigned c = lcnt[tid]; lcnt[32 + tid] = c ? atomicAdd(cnt + tid, c) : 0u; }
    __syncthreads();
    { int* TOKL = (int*)(ws + WS_TOKL); int* ASSIGN = (int*)(ws + WS_ASSIGN); float* GATE = (float*)(ws + WS_GATE); float* RSL = (float*)(ws + WS_RSL);
      const u32x4 rec = *(const LAS u32x4*)(lds + R_REC + tid * 16);
      const int tt = tb * 128 + (tid >> 2); const unsigned e = rec.x, pos = lcnt[32 + e] + rec.y;
      const unsigned gbits = rec.z, rbits = rec.w;
      TOKL[e * NTOK + pos] = tt; RSL[e * NTOK + pos] = __builtin_bit_cast(float, rbits); ASSIGN[tt * 4 + (tid & 3)] = (int)((e << 16) | pos); GATE[tt * 4 + (tid & 3)] = __builtin_bit_cast(float, gbits); }
    __syncthreads();
}
__device__ __forceinline__ void route_phase(const Params& P, LAS unsigned char* lds, int tid, int lane, int wave, bool prestaged) {
    if ((int)blockIdx.x >= NTOK / 128) return;
    for (int tb = blockIdx.x; tb < NTOK / 128; tb += gridDim.x) route_block(P, lds, tb, tid, lane, wave, !prestaged && tb == (int)blockIdx.x);
}
}

__device__ __forceinline__ void expert_tiles(const unsigned* cnt, int lane, int& my_cnt, int& my_tstart) {
    const int c = (int)__hip_atomic_load(cnt + (lane & 31), __ATOMIC_RELAXED, __HIP_MEMORY_SCOPE_AGENT);
    const int tl = (c + 255) >> 8; int inc = tl;
#pragma unroll
    for (int o = 1; o < 32; o <<= 1) { const int up = __shfl_up(inc, o, 32); if ((lane & 31) >= o) inc += up; }
    my_cnt = c; my_tstart = inc - tl;
}

__device__ __forceinline__ void p7_combine(const Params& P, int gw, int ngw, int lane, float* dstbase) {
    typedef float f32x2 __attribute__((ext_vector_type(2)));
    unsigned char* ws = P.ws;
    const unsigned char* Y = (const unsigned char*)(ws + WS_Y); const u32x4* ASSIGN = (const u32x4*)(ws + WS_ASSIGN); const f32x4* GATE = (const f32x4*)(ws + WS_GATE);
    const unsigned* cnt = (const unsigned*)(ws + WS_CTL) + CW_CNT;
    int mycnt, myts; expert_tiles(cnt, lane, mycnt, myts);
    f32x4 gf4[4];
#pragma unroll
    for (int j = 0; j < 4; ++j) gf4[j] = *((const f32x4*)P.gf + 4 * lane + j);
    int t0 = 2 * gw; if (t0 >= NTOK) return;
    u32x4 an[2]; f32x4 gn[2];
#pragma unroll
    for (int q = 0; q < 2; ++q) { an[q] = ASSIGN[t0 + q]; gn[q] = GATE[t0 + q]; }
    for (; t0 < NTOK; t0 += 2 * ngw) {
        u32x4 a[2]; f32x4 g[2];
#pragma unroll
        for (int q = 0; q < 2; ++q) { a[q] = an[q]; g[q] = gn[q]; }
        const int tn = (t0 + 2 * ngw < NTOK) ? t0 + 2 * ngw : t0;
#pragma unroll
        for (int q = 0; q < 2; ++q) { an[q] = ASSIGN[tn + q]; gn[q] = GATE[tn + q]; }
        u32x4 yv[2][4], xa[2], xb[2];
#pragma unroll
        for (int q = 0; q < 2; ++q) { const u32x4* xr = (const u32x4*)((const bf16_t*)(ws + WS_X1B) + (size_t)(t0 + q) * DM) + 2 * lane; xa[q] = xr[0]; xb[q] = xr[1];
            const unsigned aw[4] = {a[q].x, a[q].y, a[q].z, a[q].w};
#pragma unroll
            for (int k = 0; k < 4; ++k) { const int e = (int)(aw[k] >> 16), pos = (int)(aw[k] & 0xffffu); const int ts = __shfl(myts, e); yv[q][k] = __builtin_nontemporal_load((const u32x4*)(Y + ((size_t)ts * 256 + pos) * DM) + lane); } }
#pragma unroll
        for (int q = 0; q < 2; ++q) {
            f32x4 v[4];
            v[0] = (f32x4){bflo(xa[q].x), bfhi(xa[q].x), bflo(xa[q].y), bfhi(xa[q].y)}; v[1] = (f32x4){bflo(xa[q].z), bfhi(xa[q].z), bflo(xa[q].w), bfhi(xa[q].w)};
            v[2] = (f32x4){bflo(xb[q].x), bfhi(xb[q].x), bflo(xb[q].y), bfhi(xb[q].y)}; v[3] = (f32x4){bflo(xb[q].z), bfhi(xb[q].z), bflo(xb[q].w), bfhi(xb[q].w)};
            const float gk[4] = {g[q].x * (1.0f / Y_FP8_SCALE), g[q].y * (1.0f / Y_FP8_SCALE), g[q].z * (1.0f / Y_FP8_SCALE), g[q].w * (1.0f / Y_FP8_SCALE)};
#pragma unroll
            for (int k = 0; k < 4; ++k) { const unsigned yw[4] = {yv[q][k].x, yv[q][k].y, yv[q][k].z, yv[q][k].w};
#pragma unroll
                for (int j = 0; j < 4; ++j) { const f32x2 lo = __builtin_amdgcn_cvt_pk_f32_fp8((int)yw[j], false), hi = __builtin_amdgcn_cvt_pk_f32_fp8((int)yw[j], true);
                    v[j].x += gk[k] * lo.x; v[j].y += gk[k] * lo.y; v[j].z += gk[k] * hi.x; v[j].w += gk[k] * hi.y; } }
            float ss = 0.f;
#pragma unroll
            for (int j = 0; j < 4; ++j) ss += (v[j].x * v[j].x + v[j].y * v[j].y) + (v[j].z * v[j].z + v[j].w * v[j].w);
            const float rstd = 1.0f / sqrtf(wave_sum(ss) * (1.0f / DM) + EPS);
            f32x4* dr = (f32x4*)(dstbase + (size_t)(t0 + q) * DM) + 4 * lane;
#pragma unroll
            for (int j = 0; j < 4; ++j) dr[j] = v[j] * rstd * gf4[j];
        }
    }
}

namespace pg8 {
constexpr int BM = 256, BK = 64, HALF = 128, HTB = HALF * BK * 2, STAGE_BYTES = 8 * HTB, NXCD = 8, WGM = 8;
constexpr int EPI_SLOT_OFF = 131072 + 10240 + 512;
__host__ __device__ __forceinline__ int lds_byte(int r, int c) { const int st = (r >> 4) * 2 + (c >> 5), rr = r & 15, cc = c & 31, ob = rr * 64 + cc * 2; return st * 1024 + (ob ^ (((ob >> 9) & 1) << 5)); }
__host__ __device__ __forceinline__ void stage_rc(int b, int& R, int& C) { const int st = b / 1024, sb = b % 1024, swz = sb ^ (((sb >> 9) & 1) << 5); R = (st >> 1) * 16 + swz / 64; C = (st & 1) * 32 + (swz % 64) / 2; }
__host__ __device__ __forceinline__ int perm32(int rho) { const int n = rho >> 4, i = rho & 15; return 8 * (i >> 2) + 4 * n + (i & 3); }
struct Unit { int pm, pn, e, rt; };

__device__ __forceinline__ bool tile_order(int i, int G, int c, int nM, int nN, int& pm, int& pn) {
    const int nwg = nM * nN; const long L = (long)i * G + c; if (L >= nwg) return false;
    int wgid = (int)L; { const int q = nwg / NXCD, r = nwg % NXCD, xcd = wgid % NXCD, off = wgid / NXCD; wgid = (xcd < r ? xcd * (q + 1) : r * (q + 1) + (xcd - r) * q) + off; }
    const int nig = WGM * nN, gid = wgid / nig, fm = gid * WGM, gsz = (nM - fm) < WGM ? (nM - fm) : WGM;
    pm = fm + ((wgid % nig) % gsz); pn = (wgid % nig) / gsz; return true;
}
struct DenseOrder {
    const char* A; const char* Bt; int nM, nN, G, c; size_t tstep;
    __device__ __forceinline__ void init(const void* A_, const void* Bt_, int M, int N, int KB, int G_, int c_) { A = (const char*)A_; Bt = (const char*)Bt_; nM = M / BM; nN = N / BM; G = G_; c = c_; tstep = (size_t)BM * KB; }
    __device__ __forceinline__ bool next(int i, Unit& u) const { u.e = 0; u.rt = 0; return tile_order(i, G, c, nM, nN, u.pm, u.pn); }
    __device__ __forceinline__ const char* a_base(const Unit& u) const { return A + (size_t)u.pm * tstep; }
    __device__ __forceinline__ const char* b_base(const Unit& u) const { return Bt + (size_t)u.pn * tstep; }
    __device__ __forceinline__ void a_rows(const Unit&, unsigned (&)[2][2]) const {}
    __device__ __forceinline__ void a_rows_stage(const Unit&, LAS unsigned char*, int, int) const {}
    __device__ __forceinline__ void a_rows_lds(const Unit&, const LAS unsigned char*, unsigned (&)[2][2]) const {}
};
struct GroupedOrder {
    const char* A; const char* Bt; const int* tokl; const LAS int* tab; int NT, nN, G, c, KA, KB; size_t bexp;
    __device__ __forceinline__ bool next(int i, Unit& u) const {
        if (!tile_order(i, G, c, NT, nN, u.pm, u.pn)) return false;
        const int ts = tab[threadIdx.x & 31];
        const unsigned long long bal = __ballot(ts <= u.pm);
        const int e = __builtin_popcount((unsigned)bal) - 1;
        u.e = __builtin_amdgcn_readfirstlane(e); u.rt = u.pm - __builtin_amdgcn_readfirstlane(tab[u.e]); return true;
    }
    __device__ __forceinline__ const char* a_base(const Unit& u) const { return tokl ? A : A + (size_t)u.pm * BM * KA; }
    __device__ __forceinline__ const char* b_base(const Unit& u) const { return Bt + (size_t)u.e * bexp + (size_t)u.pn * BM * KB; }
    __device__ __forceinline__ void a_rows(const Unit& u, unsigned (&gv)[2][2]) const {
        const int ce = __builtin_amdgcn_readfirstlane(tab[32 + u.e]);
#pragma unroll
        for (int h = 0; h < 2; ++h)
#pragma unroll
            for (int i = 0; i < 2; ++i) { int R, C; stage_rc((int)threadIdx.x * 16 + i * 8192, R, C);
                const int pos = u.rt * BM + h * HALF + R; const int tok = pos < ce ? tokl[u.e * NTOK + pos] : 0; gv[h][i] = (unsigned)tok * (unsigned)KA + (unsigned)(C * 2); }
    }
    __device__ __forceinline__ void a_rows_stage(const Unit& u, LAS unsigned char* slot, int wid, int lane) const {
        if (wid == 2) __builtin_amdgcn_global_load_lds((const unsigned*)(tokl + (size_t)u.e * NTOK + u.rt * BM + 4 * lane), (LAS unsigned*)slot, 16, 0, 0);
    }
    __device__ __forceinline__ void a_rows_lds(const Unit& u, const LAS unsigned char* slot, unsigned (&gv)[2][2]) const {
        const int ce = __builtin_amdgcn_readfirstlane(tab[32 + u.e]);
#pragma unroll
        for (int h = 0; h < 2; ++h)
#pragma unroll
            for (int i = 0; i < 2; ++i) { int R, C; stage_rc((int)threadIdx.x * 16 + i * 8192, R, C);
                const int pl = h * HALF + R; const int tv = ((const LAS int*)slot)[pl]; const int tok = (u.rt * BM + pl) < ce ? tv : 0; gv[h][i] = (unsigned)tok * (unsigned)KA + (unsigned)(C * 2); }
    }
};

__device__ __forceinline__ unsigned cvt_pk_bf16(float lo, float hi) { unsigned r; asm volatile("v_cvt_pk_bf16_f32 %0, %1, %2" : "=v"(r) : "v"(lo), "v"(hi)); return r; }

typedef int v8i32 __attribute__((ext_vector_type(8)));
typedef unsigned u32x8 __attribute__((ext_vector_type(8)));
template <bool GATHER, bool FP8, class Epi, class Sched, bool ALIGN_EPI>
__device__ __forceinline__ void gemm_phase(LAS unsigned char* lds, const int KB, const Sched& S, const Epi& E) {
    const int tid = threadIdx.x, wid = __builtin_amdgcn_readfirstlane(tid >> 6), lane = tid & 63, wr = wid >> 2, wc = wid & 3, fr = lane & 15, fq = lane >> 4;
    const int nt = KB / 128;
    unsigned voffA[2], voffB[2];
#pragma unroll
    for (int i = 0; i < 2; ++i) { int R, C; stage_rc(tid * 16 + i * 8192, R, C);
        const int Rb = (int)Epi::PERM == 3 ? (64 * (R >> 5) + 16 * ((R & 15) >> 2) + 4 * ((R >> 4) & 1) + (((R & 1) << 1) | ((R >> 1) & 1))) : (int)Epi::PERM == 2 ? (64 * (R >> 5) + 16 * ((R & 15) >> 2) + 4 * ((R >> 4) & 1) + (R & 3)) : (int)Epi::PERM == 1 ? ((R & ~31) + perm32(R & 31)) : R;
        voffA[i] = (unsigned)(R * KB + C * 2); voffB[i] = (unsigned)(Rb * KB + C * 2); }
    const size_t kstep = (size_t)(BK * 2);
    const size_t hstep = (size_t)HALF * KB;
    const size_t hstepA = GATHER ? (size_t)0 : hstep;
    const size_t hstepB = (int)Epi::PERM >= 2 ? (size_t)8 * KB : hstep;
    const unsigned ldsw = (unsigned)wid * 1024u;
    const int aoff = lds_byte(wr * 64 + fr, fq * 8), boff = lds_byte(wc * 32 + fr, fq * 8);
#define PG8_SA(b, h) (((b) * 2 + (h)) * HTB)
#define PG8_SB(b, h) ((4 + (b) * 2 + (h)) * HTB)
#define PG8_STAGE(bufoff, gbase, voff) do { _Pragma("unroll") for (int _i = 0; _i < 2; ++_i) \
        __builtin_amdgcn_global_load_lds((const unsigned*)((const char*)(gbase) + (voff)[_i]), (LAS unsigned*)(lds + (bufoff) + ldsw + _i * 8192), 16, 0, 0); } while (0)
#define PG8_STAGE_A(bufoff, gbase, h, gvsel) do { if constexpr (GATHER) { PG8_STAGE(bufoff, gbase, gvsel[h]); } else { PG8_STAGE(bufoff, gbase, voffA); } } while (0)
#define PG8_LD32(addr) (u32x8)__builtin_shufflevector(*(const LAS u32x4*)(addr), *(const LAS u32x4*)((addr) + 1024), 0, 1, 2, 3, 4, 5, 6, 7)
#define PG8_LDA(dst, b, h) do { if constexpr (FP8) { _Pragma("unroll") for (int m = 0; m < 4; ++m) dst##8[m] = PG8_LD32(lds + PG8_SA(b, h) + aoff + m * 2048); } \
    else { _Pragma("unroll") for (int m = 0; m < 4; ++m) _Pragma("unroll") for (int k = 0; k < 2; ++k) dst[m][k] = *(const LAS bf16x8*)(lds + PG8_SA(b, h) + aoff + m * 2048 + k * 1024); } } while (0)
#define PG8_LDB(dst, b, h) do { if constexpr (FP8) { _Pragma("unroll") for (int n = 0; n < 2; ++n) dst##8[n] = PG8_LD32(lds + PG8_SB(b, h) + boff + n * 2048); } \
    else { _Pragma("unroll") for (int n = 0; n < 2; ++n) _Pragma("unroll") for (int k = 0; k < 2; ++k) dst[n][k] = *(const LAS bf16x8*)(lds + PG8_SB(b, h) + boff + n * 2048 + k * 1024); } } while (0)
#define PG8_MMA(ai, bj, At, Bt) do { __builtin_amdgcn_s_setprio(1); if constexpr (FP8) { _Pragma("unroll") for (int m = 0; m < 4; ++m) _Pragma("unroll") for (int n = 0; n < 2; ++n) \
        asm volatile("v_mfma_f32_16x16x128_f8f6f4 %0, %1, %2, %0" : "+v"(acc[ai][bj][m][n]) : "v"(Bt##8[n]), "v"(At##8[m])); } \
    else { _Pragma("unroll") for (int m = 0; m < 4; ++m) _Pragma("unroll") for (int n = 0; n < 2; ++n) _Pragma("unroll") for (int k = 0; k < 2; ++k) \
        acc[ai][bj][m][n] = __builtin_amdgcn_mfma_f32_16x16x32_bf16(Bt[n][k], At[m][k], acc[ai][bj][m][n], 0, 0, 0); } __builtin_amdgcn_s_setprio(0); } while (0)
#define PG8_MMAZ(ai, bj, At, Bt, z) do { if constexpr (FP8) { if (z) { __builtin_amdgcn_s_setprio(1); _Pragma("unroll") for (int m = 0; m < 4; ++m) _Pragma("unroll") for (int n = 0; n < 2; ++n) \
        asm volatile("v_mfma_f32_16x16x128_f8f6f4 %0, %1, %2, 0" : "=&v"(acc[ai][bj][m][n]) : "v"(Bt##8[n]), "v"(At##8[m])); __builtin_amdgcn_s_setprio(0); } else PG8_MMA(ai, bj, At, Bt); } else PG8_MMA(ai, bj, At, Bt); } while (0)
#define PG8_WAIT_V(n) asm volatile("s_waitcnt vmcnt(" #n ")" ::: "memory")
#define PG8_WAIT_L(n) asm volatile("s_waitcnt lgkmcnt(" #n ")" ::: "memory")
#define PG8_BAR __builtin_amdgcn_s_barrier()
#define PG8_SCHED __builtin_amdgcn_sched_barrier(0)
    Unit cur, nxt; int ui = 0;
    if (!S.next(0, cur)) return;
    f32x4 acc[2][2][4][2];
    if constexpr (!FP8) {
#pragma unroll
    for (int a = 0; a < 2; ++a)
#pragma unroll
        for (int b = 0; b < 2; ++b)
#pragma unroll
            for (int m = 0; m < 4; ++m)
#pragma unroll
                for (int n = 0; n < 2; ++n) acc[a][b][m][n] = (f32x4){0.f, 0.f, 0.f, 0.f};
    }
    bf16x8 At[4][2], B0[2][2], B1[2][2]; u32x8 At8[4], B08[2], B18[2];
    const char* cA = S.a_base(cur); const char* cB = S.b_base(cur);
    unsigned gvc[2][2] = {{0u, 0u}, {0u, 0u}};
    LAS unsigned char* tslot = lds + EPI_SLOT_OFF + 4096;
    if constexpr (GATHER) S.a_rows(cur, gvc);
    PG8_STAGE(PG8_SB(0, 0), cB, voffB); PG8_STAGE(PG8_SB(0, 1), cB + hstepB, voffB); PG8_STAGE_A(PG8_SA(0, 0), cA, 0, gvc); PG8_STAGE_A(PG8_SA(0, 1), cA + hstepA, 1, gvc);
    if (wr == 1) PG8_BAR;
    PG8_WAIT_V(2); PG8_BAR;
    PG8_STAGE(PG8_SB(1, 0), cB + kstep, voffB); PG8_STAGE_A(PG8_SA(1, 0), cA + kstep, 0, gvc); PG8_STAGE(PG8_SB(1, 1), cB + hstepB + kstep, voffB);
    PG8_WAIT_V(6); PG8_BAR;
    for (;;) {
        const bool has_next = S.next(ui + 1, nxt);
        const char* nA = has_next ? S.a_base(nxt) : cA; const char* nB = has_next ? S.b_base(nxt) : cB;
        if constexpr (GATHER) { if (has_next) S.a_rows_stage(nxt, tslot, wid, lane); }
        LAS unsigned char* eslot = lds + EPI_SLOT_OFF + (ui & 1) * 2048;
        E.stage(cur, eslot, wid, lane);
#pragma unroll 1
        for (int t = 0; t < nt; t += 2) {
            const bool last = (t == nt - 2), first = (t == 0);
            const char* a1 = cA + (size_t)(t + 1) * kstep;
            const char* a2 = last ? nA : cA + (size_t)(t + 2) * kstep; const char* b2 = last ? nB : cB + (size_t)(t + 2) * kstep;
            const char* a3 = a2 + kstep; const char* b3 = b2 + kstep;
            PG8_LDB(B0, 0, 0); PG8_LDB(B1, 0, 1); PG8_SCHED; PG8_LDA(At, 0, 0); PG8_STAGE_A(PG8_SA(1, 1), a1 + hstepA, 1, gvc);
            if constexpr (GATHER) { if (last && has_next) S.a_rows_lds(nxt, tslot, gvc); }
            PG8_WAIT_V(8); PG8_WAIT_L(0); PG8_BAR; PG8_MMAZ(0, 0, At, B0, first); PG8_MMAZ(0, 1, At, B1, first); PG8_BAR; PG8_SCHED;
            PG8_LDA(At, 0, 1); PG8_STAGE(PG8_SB(0, 0), b2, voffB); PG8_STAGE(PG8_SB(0, 1), b2 + hstepB, voffB); PG8_STAGE_A(PG8_SA(0, 0), a2, 0, gvc);
            PG8_WAIT_V(8); PG8_WAIT_L(0); PG8_BAR; PG8_MMAZ(1, 0, At, B0, first); PG8_MMAZ(1, 1, At, B1, first); PG8_BAR; PG8_SCHED;
            PG8_LDB(B0, 1, 0); PG8_LDB(B1, 1, 1); PG8_SCHED; PG8_LDA(At, 1, 0); PG8_STAGE_A(PG8_SA(0, 1), a2 + hstepA, 1, gvc);
            PG8_WAIT_V(8); PG8_WAIT_L(0); PG8_BAR; PG8_MMA(0, 0, At, B0); PG8_MMA(0, 1, At, B1); PG8_BAR; PG8_SCHED;
            PG8_LDA(At, 1, 1); PG8_STAGE(PG8_SB(1, 0), b3, voffB); PG8_STAGE(PG8_SB(1, 1), b3 + hstepB, voffB); PG8_STAGE_A(PG8_SA(1, 0), a3, 0, gvc);
            PG8_WAIT_V(8); PG8_WAIT_L(0); PG8_BAR; PG8_MMA(1, 0, At, B0); PG8_MMA(1, 1, At, B1); PG8_BAR; PG8_SCHED;
        }
        if constexpr (ALIGN_EPI) { if (wr == 0) PG8_BAR; }
        if constexpr (FP8) asm volatile("s_nop 15\n\ts_nop 15" ::: "memory");
        E(acc, cur, wr, wc, fr, fq, eslot);
        if (!has_next) break;
        if constexpr (!FP8)
#pragma unroll
        for (int a = 0; a < 2; ++a)
#pragma unroll
            for (int b = 0; b < 2; ++b)
#pragma unroll
                for (int m = 0; m < 4; ++m)
#pragma unroll
                    for (int n = 0; n < 2; ++n) acc[a][b][m][n] = (f32x4){0.f, 0.f, 0.f, 0.f};
        cur = nxt; cA = nA; cB = nB; ++ui;
        if constexpr (ALIGN_EPI) { if (wr == 1) PG8_BAR; }
    }
    PG8_WAIT_V(0);
    if constexpr (!ALIGN_EPI) { if (wr == 0) PG8_BAR; }
    PG8_BAR;
#undef PG8_SA
#undef PG8_SB
#undef PG8_STAGE
#undef PG8_STAGE_A
#undef PG8_LDA
#undef PG8_LDB
#undef PG8_MMA
#undef PG8_MMAZ
#undef PG8_LD32
#undef PG8_WAIT_V
#undef PG8_WAIT_L
#undef PG8_BAR
#undef PG8_SCHED
}

struct EpiQKV {
    static constexpr int PERM = 1;
    bf16_t* QKV; const float* bias; const float* RC; const float* RS;
    __device__ __forceinline__ void stage(const Unit&, LAS unsigned char*, int, int) const {}
    __device__ __forceinline__ void operator()(const f32x4 (&acc)[2][2][4][2], const Unit& u, int wr, int wc, int fr, int fq, const LAS unsigned char*) const {
        const int hs = u.pn * 4 + wc; const bool rope = (hs < 16) || (hs >= 24 && hs < 34); const float sc = (hs < 8 || (hs >= 24 && hs < 32)) ? QSCALE : 1.0f;
        f32x4 bv[2][2];
#pragma unroll
        for (int bj = 0; bj < 2; ++bj)
#pragma unroll
            for (int n = 0; n < 2; ++n) bv[bj][n] = *(const f32x4*)(bias + hs * 64 + 32 * bj + 8 * fq + 4 * n);
#pragma unroll
        for (int ai = 0; ai < 2; ++ai) {
            f32x4 cs[4][2], sn[4][2];
#pragma unroll
            for (int m = 0; m < 4; ++m) { const size_t t = (size_t)(u.pm * BM + ai * HALF + wr * 64 + m * 16 + fr);
#pragma unroll
                for (int n = 0; n < 2; ++n) { if (rope) { cs[m][n] = *(const f32x4*)(RC + t * 32 + 8 * fq + 4 * n); sn[m][n] = *(const f32x4*)(RS + t * 32 + 8 * fq + 4 * n); }
                    else { cs[m][n] = (f32x4){1.f, 1.f, 1.f, 1.f}; sn[m][n] = (f32x4){0.f, 0.f, 0.f, 0.f}; } } }
            asm volatile("" ::: "memory");
#pragma unroll
            for (int m = 0; m < 4; ++m) { const int t = u.pm * BM + ai * HALF + wr * 64 + m * 16 + fr;
                f32x4 o1[2], o2[2];
#pragma unroll
                for (int n = 0; n < 2; ++n) { const f32x4 v1 = acc[ai][0][m][n] + bv[0][n], v2 = acc[ai][1][m][n] + bv[1][n];
                    o1[n] = (v1 * cs[m][n] - v2 * sn[m][n]) * sc; o2[n] = (v2 * cs[m][n] + v1 * sn[m][n]) * sc; }
                bf16_t* dst = QKV + ((size_t)hs * NTOK + t) * 64 + 8 * fq;
                u32x4 w1, w2; w1.x = cvt_pk_bf16(o1[0][0], o1[0][1]); w1.y = cvt_pk_bf16(o1[0][2], o1[0][3]); w1.z = cvt_pk_bf16(o1[1][0], o1[1][1]); w1.w = cvt_pk_bf16(o1[1][2], o1[1][3]);
                w2.x = cvt_pk_bf16(o2[0][0], o2[0][1]); w2.y = cvt_pk_bf16(o2[0][2], o2[0][3]); w2.z = cvt_pk_bf16(o2[1][0], o2[1][1]); w2.w = cvt_pk_bf16(o2[1][2], o2[1][3]);
                *(u32x4*)dst = w1; *(u32x4*)(dst + 32) = w2; }
        }
    }
};
struct EpiOut {
    static constexpr int PERM = 1;
    const bf16_t* h1; const float* sr1; const float* g1; bf16_t* x1b; const float* bias; float oscale;
    __device__ __forceinline__ void stage(const Unit& u, LAS unsigned char* slot, int wid, int lane) const {
        if (wid == 0) __builtin_amdgcn_global_load_lds((const unsigned*)(sr1 + u.pm * BM + 4 * lane), (LAS unsigned*)slot, 16, 0, 0);
    }
    __device__ __forceinline__ void operator()(const f32x4 (&acc)[2][2][4][2], const Unit& u, int wr, int wc, int fr, int fq, const LAS unsigned char* slot) const {
        const int col0 = u.pn * BM + wc * 32 + 8 * fq;
        const LAS float* srp = (const LAS float*)slot + wr * 64 + fr;
        f32x4 bv[2][2], gi[2][2];
#pragma unroll
        for (int bj = 0; bj < 2; ++bj)
#pragma unroll
            for (int n = 0; n < 2; ++n) { bv[bj][n] = *(const f32x4*)(bias + col0 + bj * HALF + 4 * n); const f32x4 g = *(const f32x4*)(g1 + col0 + bj * HALF + 4 * n);
                gi[bj][n] = (f32x4){__builtin_amdgcn_rcpf(g[0]), __builtin_amdgcn_rcpf(g[1]), __builtin_amdgcn_rcpf(g[2]), __builtin_amdgcn_rcpf(g[3])}; }
#pragma unroll
        for (int ai = 0; ai < 2; ++ai) {
            u32x4 hv[4][2];
#pragma unroll
            for (int m = 0; m < 4; ++m) { const size_t off = (size_t)(u.pm * BM + ai * HALF + wr * 64 + m * 16 + fr) * DM + col0;
#pragma unroll
                for (int bj = 0; bj < 2; ++bj) hv[m][bj] = __builtin_nontemporal_load((const u32x4*)(h1 + off + bj * HALF)); }
            asm volatile("" ::: "memory");
#pragma unroll
            for (int m = 0; m < 4; ++m) { const size_t off = (size_t)(u.pm * BM + ai * HALF + wr * 64 + m * 16 + fr) * DM + col0; const float sr = srp[ai * HALF + m * 16];
#pragma unroll
                for (int bj = 0; bj < 2; ++bj) { const u32x4 h = hv[m][bj];
                    const f32x4 x0 = (f32x4){bflo(h.x), bfhi(h.x), bflo(h.y), bfhi(h.y)} * (gi[bj][0] * sr), x1 = (f32x4){bflo(h.z), bfhi(h.z), bflo(h.w), bfhi(h.w)} * (gi[bj][1] * sr);
                    const f32x4 v0 = x0 + acc[ai][bj][m][0] * oscale + bv[bj][0], v1 = x1 + acc[ai][bj][m][1] * oscale + bv[bj][1];
                    u32x4 w; w.x = cvt_pk_bf16(v0[0], v0[1]); w.y = cvt_pk_bf16(v0[2], v0[3]); w.z = cvt_pk_bf16(v1[0], v1[1]); w.w = cvt_pk_bf16(v1[2], v1[3]);
                    *(u32x4*)(x1b + off + bj * HALF) = w; } }
        }
    }
};
typedef float f32x2 __attribute__((ext_vector_type(2)));
struct EpiSwiglu {
    static constexpr int PERM = 3;
    unsigned char* HID; const float* b1; const float* rsl; float oscale;
    __device__ __forceinline__ void stage(const Unit& u, LAS unsigned char* slot, int wid, int lane) const {
        if (wid == 0) __builtin_amdgcn_global_load_lds((const unsigned*)(b1 + (size_t)u.e * DU + u.pn * BM + 4 * lane), (LAS unsigned*)slot, 16, 0, 0);
        if (wid == 1) __builtin_amdgcn_global_load_lds((const unsigned*)(rsl + (size_t)u.e * NTOK + u.rt * BM + 4 * lane), (LAS unsigned*)(slot + 1024), 16, 0, 0);
    }
    __device__ __forceinline__ void operator()(const f32x4 (&acc)[2][2][4][2], const Unit& u, int wr, int wc, int fr, int fq, const LAS unsigned char* slot) const {
        const int uc0 = u.pn * BM + wc * 64 + 16 * fq;
        const LAS float* bsl = (const LAS float*)slot + wc * 64 + 16 * fq; const LAS float* rsp = (const LAS float*)(slot + 1024) + wr * 64 + fr;
        f32x4 bv[2][2];
#pragma unroll
        for (int bj = 0; bj < 2; ++bj)
#pragma unroll
            for (int n = 0; n < 2; ++n) { const f32x4 b = *(const LAS f32x4*)(bsl + 8 * bj + 4 * n); bv[bj][n] = (f32x4){b[0], b[2], __builtin_fmaf(b[1], HID_FP8_SCALE, HID_FP8_SCALE), __builtin_fmaf(b[3], HID_FP8_SCALE, HID_FP8_SCALE)}; }
#pragma unroll
        for (int ai = 0; ai < 2; ++ai)
#pragma unroll
            for (int m = 0; m < 4; ++m) { f32x2 hv[4]; const float rs = rsp[ai * HALF + m * 16] * oscale, rss = rs * HID_FP8_SCALE; const f32x4 rs4 = (f32x4){rs, rs, rss, rss};
#pragma unroll
                for (int bj = 0; bj < 2; ++bj)
#pragma unroll
                    for (int n = 0; n < 2; ++n) { const f32x4 v = acc[ai][bj][m][n] * rs4 + bv[bj][n];
                        const f32x2 g = (f32x2){fminf(v[0], 7.0f), fminf(v[1], 7.0f)};
                        const f32x2 l = (f32x2){__builtin_amdgcn_fmed3f(v[2], -6.0f * HID_FP8_SCALE, 8.0f * HID_FP8_SCALE), __builtin_amdgcn_fmed3f(v[3], -6.0f * HID_FP8_SCALE, 8.0f * HID_FP8_SCALE)};
                        const f32x2 t = g * (-1.702f * LOG2E);
                        const f32x2 d = (f32x2){__builtin_amdgcn_exp2f(t[0]), __builtin_amdgcn_exp2f(t[1])} + 1.0f;
                        const f32x2 r = (f32x2){__builtin_amdgcn_rcpf(d[0]), __builtin_amdgcn_rcpf(d[1])};
                        hv[2 * bj + n] = (g * r) * l; }
                u32x2 w; w.x = pk4_fp8(hv[0][0], hv[0][1], hv[1][0], hv[1][1]); w.y = pk4_fp8(hv[2][0], hv[2][1], hv[3][0], hv[3][1]);
                *(u32x2*)(HID + (size_t)(u.pm * BM + ai * HALF + wr * 64 + m * 16 + fr) * DFF + (uc0 >> 1)) = w; }
    }
};
struct EpiY {
    static constexpr int PERM = 2;
    unsigned char* Y; const float* b2; float oscale;
    __device__ __forceinline__ void stage(const Unit& u, LAS unsigned char* slot, int wid, int lane) const {
        if (wid == 0) __builtin_amdgcn_global_load_lds((const unsigned*)(b2 + (size_t)u.e * DM + u.pn * BM + 4 * lane), (LAS unsigned*)slot, 16, 0, 0);
    }
    __device__ __forceinline__ void operator()(const f32x4 (&acc)[2][2][4][2], const Unit& u, int wr, int wc, int fr, int fq, const LAS unsigned char* slot) const {
        const int col0 = u.pn * BM + wc * 64 + 16 * fq;
        const LAS float* bsl = (const LAS float*)slot + wc * 64 + 16 * fq;
        f32x4 bv[2][2];
#pragma unroll
        for (int bj = 0; bj < 2; ++bj)
#pragma unroll
            for (int n = 0; n < 2; ++n) bv[bj][n] = *(const LAS f32x4*)(bsl + 8 * bj + 4 * n) * Y_FP8_SCALE;
        const float os = oscale * Y_FP8_SCALE;
#pragma unroll
        for (int ai = 0; ai < 2; ++ai)
#pragma unroll
            for (int m = 0; m < 4; ++m) { u32x4 w;
                { const f32x4 v = acc[ai][0][m][0] * os + bv[0][0]; w.x = pk4_fp8(v[0], v[1], v[2], v[3]); }
                { const f32x4 v = acc[ai][0][m][1] * os + bv[0][1]; w.y = pk4_fp8(v[0], v[1], v[2], v[3]); }
                { const f32x4 v = acc[ai][1][m][0] * os + bv[1][0]; w.z = pk4_fp8(v[0], v[1], v[2], v[3]); }
                { const f32x4 v = acc[ai][1][m][1] * os + bv[1][1]; w.w = pk4_fp8(v[0], v[1], v[2], v[3]); }
                *(u32x4*)(Y + (size_t)(u.pm * BM + ai * HALF + wr * 64 + m * 16 + fr) * DM + col0) = w; }
    }
};
}

#define GAS __attribute__((address_space(1)))
typedef GAS unsigned gu32;
#define RLX_AGENT __ATOMIC_RELAXED, __HIP_MEMORY_SCOPE_AGENT
#define XB_TMO      128
#define XB_XCNT(j)  (256  + 64 * (j))
#define XB_XSUB(j)  (1280 + 64 * (j))
#define XB_XGEN(j)  (2304 + 64 * (j))
#define XB_TOP      3328
#define XB_TOPGEN   3392
#define XCD_BAR_WORDS 3456
#define XB_SPIN_CAP (1u << 18)

__device__ __forceinline__ unsigned xb_ld(unsigned* p)              { return __hip_atomic_load(p, __ATOMIC_RELAXED, __HIP_MEMORY_SCOPE_AGENT); }
__device__ __forceinline__ unsigned xb_add(unsigned* p, unsigned v) { return __hip_atomic_fetch_add(p, v, __ATOMIC_RELAXED, __HIP_MEMORY_SCOPE_AGENT); }
__device__ __forceinline__ unsigned xb_xcc_id() { return (unsigned)__builtin_amdgcn_s_getreg((3 << 11) | 20) & 0xFu; }
#define XB_SPIN(cond, bar) do { unsigned _sp = 0; while (cond) { __builtin_amdgcn_s_sleep(1); \
    if ((++_sp & 255u) == 0u) { if (xb_ld(&(bar)[XB_TMO])) break; if (_sp > XB_SPIN_CAP) { atomicAdd(&(bar)[XB_TMO], 1u); break; } } } } while (0)

struct XcdBarrier {
    unsigned* bar; unsigned x;
    volatile LAS unsigned* st;
};

__device__ __forceinline__ XcdBarrier xcd_barrier_post(unsigned* bar, volatile LAS unsigned* st) {
    XcdBarrier b; b.bar = bar; b.x = xb_xcc_id(); b.st = st;
    if (threadIdx.x == 0) (void)xb_add(&bar[XB_XCNT(b.x)], 1u);
    return b;
}
__device__ __forceinline__ void xcd_barrier_complete(unsigned* bar, unsigned x, unsigned& nloc, unsigned& nx) {
    const unsigned G = gridDim.x * gridDim.y * gridDim.z;
    unsigned sum, cnt, mine, sp = 0u;
    for (;;) {
        sum = 0u; cnt = 0u; mine = 0u;
#pragma unroll
        for (unsigned j = 0; j < 16; ++j) { const unsigned c = xb_ld(&bar[XB_XCNT(j)]); sum += c; cnt += (c > 0u) ? 1u : 0u; mine = (j == x) ? c : mine; }
        if (sum == G) break;
        __builtin_amdgcn_s_sleep(1);
        if ((++sp & 255u) == 0u) { if (xb_ld(&bar[XB_TMO])) break; if (sp > XB_SPIN_CAP) { atomicAdd(&bar[XB_TMO], 1u); break; } }
    }
    nloc = mine > 0u ? mine : 1u; nx = cnt > 0u ? cnt : 1u;
}

__device__ __forceinline__ void xcd_barrier(const XcdBarrier& b) {
    asm volatile("s_waitcnt vmcnt(0)" ::: "memory");
    __syncthreads();
    if (threadIdx.x == 0) {
        unsigned* bar = b.bar;
        __builtin_amdgcn_s_waitcnt(0);
        unsigned nloc = b.st[0], nx = b.st[1];
        if (nloc == 0u) { xcd_barrier_complete(bar, b.x, nloc, nx); b.st[0] = nloc; b.st[1] = nx; }
        const unsigned round = b.st[2]; b.st[2] = round + 1u;
        const unsigned old = xb_add(&bar[XB_XSUB(b.x)], 1u);
        const unsigned gen = old / nloc;
        if (old + 1u == (gen + 1u) * nloc) {
            __builtin_amdgcn_fence(__ATOMIC_RELEASE, "agent");
            asm volatile("s_waitcnt vmcnt(0)" ::: "memory");
            (void)xb_add(&bar[XB_TOP], 1u);
        }
        const unsigned target = (round + 1u) * nx;
        XB_SPIN(xb_ld(&bar[XB_TOP]) < target, bar);
        __builtin_amdgcn_fence(__ATOMIC_ACQUIRE, "agent");
        asm volatile("s_waitcnt vmcnt(0)" ::: "memory");
    }
    __syncthreads();
}


__device__ __forceinline__ int expert_table_lds(const unsigned* cnt, LAS int* tab, int lane, int wave) {
    int mycnt, myts; expert_tiles(cnt, lane, mycnt, myts);
    if (wave == 0 && lane < 32) { tab[lane] = myts; tab[32 + lane] = mycnt; }
    __syncthreads();
    return __builtin_amdgcn_readfirstlane(__shfl(myts, 31) + ((__shfl(mycnt, 31) + 255) >> 8));
}

constexpr int NWAVES = 8;
constexpr int LDS_BYTES = 147456;
constexpr int MISC_OFF = 131072 + 320;
constexpr int TAB_OFF = 131072 + 10240;
constexpr int CW_BAR = 4096;
#ifndef MK_N_LAUNCHES
#define MK_N_LAUNCHES 1
#endif
constexpr int N_PHASES = 9;
struct Args { Params P; int ph_lo, ph_hi; };

__global__ void __launch_bounds__(NWAVES * 64, 2) mk_fwd(Args args) {
    extern __shared__ __attribute__((aligned(16))) unsigned char lds[];
    const Params& P = args.P;
    const int tid = threadIdx.x, lane = tid & 63, wave = __builtin_amdgcn_readfirstlane(tid >> 6);
    const int gw = blockIdx.x * NWAVES + wave, ngw = gridDim.x * NWAVES;
    volatile LAS unsigned* MISC = (volatile LAS unsigned*)((LAS unsigned char*)lds + MISC_OFF);
    for (int u = tid; u < 64; u += NWAVES * 64) MISC[u] = 0u;
    __syncthreads();
    XcdBarrier bar; bar.bar = (unsigned*)(P.ws + WS_CTL) + CW_BAR; bar.x = 0; bar.st = nullptr;
    const int lo = args.ph_lo, hi = args.ph_hi;
    if (hi - lo > 1) bar = xcd_barrier_post((unsigned*)(P.ws + WS_CTL) + CW_BAR, MISC + 8);
#define IN(k) (lo <= (k) && (k) < hi)
#define SEAM(k) do { if (IN(k) && IN((k) + 1)) xcd_barrier(bar); } while (0)
#define RUN(k, ...) do { if (IN(k)) { __VA_ARGS__; } } while (0)
    const bool split_p1 = (gridDim.x == 256) && IN(0) && IN(1);
    constexpr int CONV_Y0 = 24, TI_P0X = 13500, TI_P0 = TI_IN + TI_OUT + TI_P0X;
    RUN(0, p0_prologue(P, gw, ngw, lane, (LAS float*)lds + wave * (64 * 36), split_p1 ? TI_P0 : TI_ALL));
    SEAM(0);
    RUN(1, {
        const int xl = (int)blockIdx.x & 7, yl = (int)blockIdx.x >> 3;
        if (split_p1 && yl >= CONV_Y0) weight_items(P, TI_P0, TI_ALL, ((yl - CONV_Y0) * 8 + xl) * NWAVES + wave, (32 - CONV_Y0) * 8 * NWAVES, lane, (LAS float*)lds + wave * (64 * 36));
        else {
            pg8::DenseOrder S; S.init(P.ws + WS_H1, P.ws + WS_WIN, NTOK, D_IN, DM * 2, split_p1 ? CONV_Y0 * 8 : (int)gridDim.x, split_p1 ? yl * 8 + xl : (int)blockIdx.x);
            const float* RC = (const float*)(P.ws + WS_ROPE);
            pg8::EpiQKV E{(bf16_t*)(P.ws + WS_QKV), P.b_in, RC, RC + (size_t)NTOK * 32};
            pg8::gemm_phase<false, false, pg8::EpiQKV, pg8::DenseOrder, true>((LAS unsigned char*)lds, DM * 2, S, E);
        }
    });
    SEAM(1);
    RUN(2, att::attn_phase(P, (LAS unsigned char*)lds, tid, lane, wave));
    SEAM(2);
    RUN(3, p2b_merge(P, gw, ngw, lane));
    SEAM(3);
    RUN(4, {
        pg8::DenseOrder S; S.init(P.ws + WS_MIXED, P.ws + WS_WOUT, NTOK, DM, DM, (int)gridDim.x, (int)blockIdx.x);
        pg8::EpiOut E{(const bf16_t*)(P.ws + WS_H1), (const float*)(P.ws + WS_SR1), P.g1, (bf16_t*)(P.ws + WS_X1B), P.b_out, 1.0f / (W_FP8_SCALE * MIX_FP8_SCALE)};
        pg8::gemm_phase<false, true, pg8::EpiOut, pg8::DenseOrder, true>((LAS unsigned char*)lds, DM, S, E);
        if (IN(5) && (int)blockIdx.x < NTOK / 128) route::stage_weights(P, (LAS unsigned char*)lds, tid);
    });
    SEAM(4);
    RUN(5, route::route_phase(P, (LAS unsigned char*)lds, tid, lane, wave, IN(4)));
    SEAM(5);
    RUN(6, {
        LAS int* tab = (LAS int*)((LAS unsigned char*)lds + TAB_OFF);
        const int NT = expert_table_lds((const unsigned*)(P.ws + WS_CTL) + CW_CNT, tab, lane, wave);
        pg8::GroupedOrder S{(const char*)(P.ws + WS_H2), (const char*)(P.ws + WS_W1), (const int*)(P.ws + WS_TOKL), tab, NT, DU / 256, (int)gridDim.x, (int)blockIdx.x, DM, DM, (size_t)DU * DM};
        pg8::EpiSwiglu E{(unsigned char*)(P.ws + WS_HID), P.b1, (const float*)(P.ws + WS_RSL), 1.0f / (W_FP8_SCALE * H2_FP8_SCALE)};
        pg8::gemm_phase<true, true, pg8::EpiSwiglu, pg8::GroupedOrder, true>((LAS unsigned char*)lds, DM, S, E);
    });
    SEAM(6);
    RUN(7, {
        LAS int* tab = (LAS int*)((LAS unsigned char*)lds + TAB_OFF);
        const int NT = expert_table_lds((const unsigned*)(P.ws + WS_CTL) + CW_CNT, tab, lane, wave);
        pg8::GroupedOrder S{(const char*)(P.ws + WS_HID), (const char*)(P.ws + WS_W2), nullptr, tab, NT, DM / 256, (int)gridDim.x, (int)blockIdx.x, DFF, DFF, (size_t)DM * DFF};
        pg8::EpiY E{(unsigned char*)(P.ws + WS_Y), P.b2, 1.0f / (W_FP8_SCALE * HID_FP8_SCALE)};
        pg8::gemm_phase<false, true, pg8::EpiY, pg8::GroupedOrder, true>((LAS unsigned char*)lds, DFF, S, E);
    });
    SEAM(7);
    RUN(8, p7_combine(P, gw, ngw, lane, P.out));
#undef IN
#undef SEAM
#undef RUN
}

extern "C" void kernel_launch(void* const* d_in, const int* in_sizes, int n_in, void* d_out, int out_size, void* d_ws, size_t ws_size, hipStream_t stream) {
    static int grid = 0;
    if (grid == 0) {
        if (n_in != 18 || out_size != NTOK * DM || ws_size < WS_END) { fprintf(stderr, "kernel_launch: unexpected shapes (n_in %d out %d ws %zu)\n", n_in, out_size, ws_size); grid = -1; return; }
        int dev = 0, cus = 0, per_cu = 0;
        if (hipGetDevice(&dev) != hipSuccess || hipDeviceGetAttribute(&cus, hipDeviceAttributeMultiprocessorCount, dev) != hipSuccess) { fprintf(stderr, "kernel_launch: device query failed\n"); grid = -1; return; }
        if (hipFuncSetAttribute((const void*)mk_fwd, hipFuncAttributeMaxDynamicSharedMemorySize, LDS_BYTES) != hipSuccess) { fprintf(stderr, "kernel_launch: hipFuncSetAttribute failed\n"); grid = -1; return; }
        if (hipOccupancyMaxActiveBlocksPerMultiprocessor(&per_cu, (const void*)mk_fwd, NWAVES * 64, LDS_BYTES) != hipSuccess || per_cu < 1) { fprintf(stderr, "kernel_launch: occupancy query says %d blocks/CU; nothing launched\n", per_cu); (void)hipGetLastError(); grid = -1; return; }
        grid = cus;
    }
    if (grid < 0) return;
    Args a{};
    Params& P = a.P;
    P.x = (const float*)d_in[0]; P.pos = (const int*)d_in[1]; P.g1 = (const float*)d_in[2]; P.w_in = (const float*)d_in[3]; P.b_in = (const float*)d_in[4];
    P.sinks = (const float*)d_in[5]; P.gn_dil = (const float*)d_in[6]; P.gn_swa = (const float*)d_in[7]; P.w_out = (const float*)d_in[8]; P.b_out = (const float*)d_in[9];
    P.g2 = (const float*)d_in[10]; P.w_router = (const float*)d_in[11]; P.b_router = (const float*)d_in[12]; P.w1 = (const float*)d_in[13]; P.b1 = (const float*)d_in[14];
    P.w2 = (const float*)d_in[15]; P.b2 = (const float*)d_in[16]; P.gf = (const float*)d_in[17]; P.out = (float*)d_out; P.ws = (unsigned char*)d_ws;
    (void)hipMemsetAsync((char*)d_ws + WS_CTL, 0, CTL_BYTES, stream);
#if MK_N_LAUNCHES == 1
    a.ph_lo = 0; a.ph_hi = N_PHASES;
    hipLaunchKernelGGL(mk_fwd, dim3(grid), dim3(NWAVES * 64), LDS_BYTES, stream, a);
#else
    for (int k = 0; k < N_PHASES; ++k) { a.ph_lo = k; a.ph_hi = k + 1; hipLaunchKernelGGL(mk_fwd, dim3(grid), dim3(NWAVES * 64), LDS_BYTES, stream, a); }
#endif
}
```

```cpp
#include <hip/hip_runtime.h>
#include <cstdio>
#include <cstdint>

#define LAS __attribute__((address_space(3)))
typedef unsigned short bf16_t;
typedef short bf16x8 __attribute__((ext_vector_type(8)));
typedef float f32x4 __attribute__((ext_vector_type(4)));
typedef unsigned u32x4 __attribute__((ext_vector_type(4)));
typedef unsigned u32x2 __attribute__((ext_vector_type(2)));

constexpr int BATCH = 8, SEQ = 4096, DM = 1024, NTOK = BATCH * SEQ;
constexpr int HD = 64, D_IN = 2304;
constexpr int NEXP = 32, DFF = 1024, DU = 2048;
constexpr float EPS = 1e-5f;
constexpr float LOG2E = 1.4426950408889634f;
constexpr float QSCALE = 0.125f * LOG2E;

constexpr size_t MiB = 1u << 20;
constexpr size_t WS_CTL = 0, CTL_BYTES = 1 * MiB;
constexpr size_t WS_WIN = 2 * MiB;
constexpr size_t WS_WRH = 7 * MiB;
constexpr size_t WS_WRL = 7 * MiB + 65536;
constexpr size_t WS_WOUT = 8 * MiB;
constexpr size_t WS_W1 = 16 * MiB;
constexpr size_t WS_W2 = 144 * MiB;
constexpr size_t WS_H1 = 208 * MiB;
constexpr size_t WS_QKV = 272 * MiB;
constexpr size_t WS_PART = 416 * MiB;
constexpr size_t WS_OSWA = 512 * MiB;
constexpr size_t WS_LSE = 544 * MiB;
constexpr size_t WS_MIXED = 548 * MiB;
constexpr size_t WS_H2 = 612 * MiB;
constexpr size_t WS_TOKL = 676 * MiB;
constexpr size_t WS_ASSIGN = 680 * MiB;
constexpr size_t WS_GATE = 680 * MiB + 512 * 1024;
constexpr size_t WS_HID = 682 * MiB;
constexpr size_t WS_ROPE = 954 * MiB;
constexpr size_t WS_RSL = 962 * MiB;
constexpr size_t WS_SR1 = 966 * MiB;
constexpr size_t WS_END = 967 * MiB;
constexpr size_t WS_X1B = 416 * MiB;
constexpr size_t WS_Y = 208 * MiB;
constexpr int CW_CNT = 1024;

struct Params {
    const float* x; const int* pos; const float* g1; const float* w_in; const float* b_in; const float* sinks;
    const float* gn_dil; const float* gn_swa; const float* w_out; const float* b_out; const float* g2;
    const float* w_router; const float* b_router; const float* w1; const float* b1; const float* w2; const float* b2; const float* gf;
    float* out; unsigned char* ws;
};

__device__ __forceinline__ unsigned f2bf(float f) { unsigned u = __builtin_bit_cast(unsigned, f); return (u + 0x7fffu + ((u >> 16) & 1u)) >> 16; }
__device__ __forceinline__ unsigned pk2(float lo, float hi) { return f2bf(lo) | (f2bf(hi) << 16); }
__device__ __forceinline__ float bf2f(unsigned h) { return __builtin_bit_cast(float, h << 16); }
__device__ __forceinline__ float bflo(unsigned w) { return __builtin_bit_cast(float, w << 16); }
__device__ __forceinline__ float bfhi(unsigned w) { return __builtin_bit_cast(float, w & 0xffff0000u); }
__device__ __forceinline__ unsigned pk4_fp8(float a, float b, float c, float d) { int w = 0; w = __builtin_amdgcn_cvt_pk_fp8_f32(a, b, w, false); w = __builtin_amdgcn_cvt_pk_fp8_f32(c, d, w, true); return (unsigned)w; }
constexpr float W_FP8_SCALE = 64.0f;
constexpr float HID_FP8_SCALE = 4.0f;
constexpr float H2_FP8_SCALE = 16.0f;
constexpr float MIX_FP8_SCALE = 16.0f;
constexpr float Y_FP8_SCALE = 16.0f;
__device__ __forceinline__ float wave_sum(float v) {
#pragma unroll
    for (int o = 1; o < 64; o <<= 1) v += __shfl_xor(v, o);
    return v;
}
__host__ __device__ __forceinline__ int qkv_phys32(int n0) { const int pn = n0 >> 8, w = n0 & 255, hh = w >> 6, bj = (w >> 5) & 1; return (pn << 8) + (bj << 7) + (hh << 5); }

template <bool FP8>
__device__ __forceinline__ void transpose_item(const float* W, int K, int N, void* WTv, bool perm, LAS float* scr, int item, int lane) {
    const int nblk = N / 32, kb = item / nblk, nb = item % nblk, k0 = 64 * kb, n0 = 32 * nb;
    const int lr = lane >> 3, lc = (lane & 7) * 4;
    f32x4 v[8];
#pragma unroll
    for (int i = 0; i < 8; ++i) v[i] = __builtin_nontemporal_load((const f32x4*)(W + (size_t)(k0 + 8 * i + lr) * N + n0 + lc));
#pragma unroll
    for (int i = 0; i < 8; ++i) *(LAS f32x4*)(scr + (8 * i + lr) * 36 + (lc ^ (i << 2))) = v[i];
    asm volatile("s_waitcnt lgkmcnt(0)" ::: "memory");
    const int c = lane & 7;
    const int ob = perm ? qkv_phys32(n0) : n0;
#pragma unroll
    for (int j = 0; j < 4; ++j) { const int n = (lane >> 3) + 8 * j; const LAS float* s = scr + (8 * c) * 36 + (n ^ (c << 2));
        if constexpr (FP8) { u32x2 o; o.x = pk4_fp8(s[0 * 36] * W_FP8_SCALE, s[1 * 36] * W_FP8_SCALE, s[2 * 36] * W_FP8_SCALE, s[3 * 36] * W_FP8_SCALE);
            o.y = pk4_fp8(s[4 * 36] * W_FP8_SCALE, s[5 * 36] * W_FP8_SCALE, s[6 * 36] * W_FP8_SCALE, s[7 * 36] * W_FP8_SCALE);
            __builtin_nontemporal_store(o, (u32x2*)((unsigned char*)WTv + (size_t)(ob + n) * K + k0 + 8 * c)); }
        else { u32x4 o; o.x = pk2(s[0 * 36], s[1 * 36]); o.y = pk2(s[2 * 36], s[3 * 36]); o.z = pk2(s[4 * 36], s[5 * 36]); o.w = pk2(s[6 * 36], s[7 * 36]);
            *(u32x4*)((bf16_t*)WTv + (size_t)(ob + n) * K + k0 + 8 * c) = o; } }
    asm volatile("s_waitcnt lgkmcnt(0)" ::: "memory");
}

constexpr int TI_IN = (DM / 64) * (D_IN / 32), TI_OUT = (DM / 64) * (DM / 32), TI_1 = (DM / 64) * (DU / 32), TI_2 = (DFF / 64) * (DM / 32);
constexpr int TI_ALL = TI_IN + TI_OUT + NEXP * (TI_1 + TI_2);
__device__ __forceinline__ void weight_items(const Params& P, int first, int last, int w, int nw, int lane, LAS float* scr) {
    unsigned char* ws = P.ws;
    bf16_t* WIN = (bf16_t*)(ws + WS_WIN); bf16_t* WOUT = (bf16_t*)(ws + WS_WOUT); bf16_t* W1T = (bf16_t*)(ws + WS_W1); bf16_t* W2T = (bf16_t*)(ws + WS_W2);
    for (int it = first + w; it < last; it += nw) {
        int r = it;
        if (r < TI_IN) { transpose_item<false>(P.w_in, DM, D_IN, WIN, true, scr, r, lane); continue; } r -= TI_IN;
        if (r < TI_OUT) { transpose_item<true>(P.w_out, DM, DM, WOUT, false, scr, r, lane); continue; } r -= TI_OUT;
        if (r < NEXP * TI_1) { const int e = r / TI_1; transpose_item<true>(P.w1 + (size_t)e * DM * DU, DM, DU, (unsigned char*)W1T + (size_t)e * DU * DM, false, scr, r % TI_1, lane); continue; } r -= NEXP * TI_1;
        { const int e = r / TI_2; transpose_item<true>(P.w2 + (size_t)e * DFF * DM, DFF, DM, (unsigned char*)W2T + (size_t)e * DM * DFF, false, scr, r % TI_2, lane); }
    }
}
__device__ __forceinline__ void p0_prologue(const Params& P, int gw, int ngw, int lane, LAS float* scr, int n_items) {
    unsigned char* ws = P.ws;
    weight_items(P, 0, n_items, gw, ngw, lane, scr);
    bf16_t* H1 = (bf16_t*)(ws + WS_H1); float* SR1 = (float*)(ws + WS_SR1);
    { f32x4 g[4];
#pragma unroll
      for (int j = 0; j < 4; ++j) g[j] = ((const f32x4*)P.g1 + lane)[64 * j];
      for (int t0 = 4 * gw; t0 < NTOK; t0 += 4 * ngw) {
        f32x4 v[4][4];
#pragma unroll
        for (int q = 0; q < 4; ++q) { const f32x4* xr = (const f32x4*)(P.x + (size_t)(t0 + q) * DM) + lane;
#pragma unroll
            for (int j = 0; j < 4; ++j) v[q][j] = __builtin_nontemporal_load(xr + 64 * j); }
#pragma unroll
        for (int q = 0; q < 4; ++q) { float ss = 0.f;
#pragma unroll
            for (int j = 0; j < 4; ++j) ss += (v[q][j].x * v[q][j].x + v[q][j].y * v[q][j].y) + (v[q][j].z * v[q][j].z + v[q][j].w * v[q][j].w);
            const float sd = sqrtf(wave_sum(ss) * (1.0f / DM) + EPS), rstd = 1.0f / sd;
            if (lane == 0) SR1[t0 + q] = sd;
            u32x2* o = (u32x2*)(H1 + (size_t)(t0 + q) * DM) + lane;
#pragma unroll
            for (int j = 0; j < 4; ++j) { u32x2 w; w.x = pk2(v[q][j].x * rstd * g[j].x, v[q][j].y * rstd * g[j].y); w.y = pk2(v[q][j].z * rstd * g[j].z, v[q][j].w * rstd * g[j].w); o[64 * j] = w; } }
      } }
    { bf16_t* WRH = (bf16_t*)(ws + WS_WRH); bf16_t* WRL = (bf16_t*)(ws + WS_WRL);
      for (int idx = gw * 64 + lane; idx < NEXP * DM; idx += ngw * 64) { const int e = idx >> 10, k = idx & 1023;
          const float w = P.w_router[k * NEXP + e]; const unsigned h = f2bf(w); WRH[idx] = (bf16_t)h; WRL[idx] = (bf16_t)f2bf(w - bf2f(h)); } }
    float* RC = (float*)(ws + WS_ROPE); float* RS = RC + (size_t)NTOK * 32;
    for (int idx = gw * 64 + lane; idx < NTOK * 32; idx += ngw * 64) {
        const int t = idx >> 5, i = idx & 31;
        const float inv = (float)exp2(-(double)i * (13.287712379549449 / 32.0));
        const float ang = (float)P.pos[t] * inv;
        const double a = (double)ang * 0.15915494309189535;
        const float fr = (float)(a - rint(a));
        RC[idx] = __builtin_amdgcn_cosf(fr); RS[idx] = __builtin_amdgcn_sinf(fr);
    }
}

namespace att {
typedef float f32x16 __attribute__((ext_vector_type(16)));
typedef short s16x4 __attribute__((ext_vector_type(4)));
constexpr int OOFF = 98304;
constexpr int KOFF = 0, VOFF = 49152;
constexpr float THR = 8.0f;
__device__ __forceinline__ int crow(int r, int hi) { return (r & 3) + 8 * (r >> 2) + 4 * hi; }
__device__ __forceinline__ s16x4 vtr(const LAS unsigned char* p) { return __builtin_bit_cast(s16x4, __builtin_amdgcn_ds_read_tr16_b64_v4i16((LAS s16x4*)p)); }
__device__ __forceinline__ void xswap(float v, float& a, float& b) { const unsigned u = __builtin_bit_cast(unsigned, v); auto rr = __builtin_amdgcn_permlane32_swap(u, u, false, false); const unsigned r0 = rr[0], r1 = rr[1]; a = __builtin_bit_cast(float, r0); b = __builtin_bit_cast(float, r1); }
__device__ __forceinline__ float xmax(float v) { float a, b; xswap(v, a, b); return fmaxf(a, b); }
__device__ __forceinline__ float xsum(float v) { float a, b; xswap(v, a, b); return a + b; }
__device__ __forceinline__ unsigned cvtpk(float lo, float hi) { unsigned r; asm("v_cvt_pk_bf16_f32 %0, %1, %2" : "=v"(r) : "v"(lo), "v"(hi)); return r; }

struct UnitInfo { int kind, h, r, nb, dm; size_t tok0; const bf16_t* qb; const bf16_t* kb; const bf16_t* vb; };
__device__ __forceinline__ UnitInfo decode(const Params& P, int unit) {
    UnitInfo u; const bf16_t* QKV = (const bf16_t*)(P.ws + WS_QKV);
    const int kind = unit >> 10, within = unit & 1023, b = within >> 7, h = (within >> 4) & 7, sub = within & 15;
    int r, c, nb, hq, hk, hv;
    if (kind == 0) { r = 1; c = 0; nb = sub; } else if (kind == 1) { r = 4; c = sub >> 2; nb = sub & 3; } else if (kind == 2) { r = 16; c = sub; nb = 0; } else { r = 1; c = 0; nb = sub; }
    if (kind < 3) { hq = h; hk = 8 + h; hv = 16 + h; u.dm = 0; } else { hq = 24 + h; hk = 32 + (h >> 2); hv = 34 + (h >> 2); u.dm = 1; }
    u.kind = kind; u.h = h; u.r = r; u.nb = nb; u.tok0 = (size_t)b * SEQ + c;
    u.qb = QKV + ((size_t)hq * NTOK + u.tok0) * 64; u.kb = QKV + ((size_t)hk * NTOK + u.tok0) * 64; u.vb = QKV + ((size_t)hv * NTOK + u.tok0) * 64;
    return u;
}
__device__ __forceinline__ void unit_loads(const UnitInfo& u, int tid, int lane, int wave, u32x4 (&kv)[6], u32x4 (&vv)[6], bf16x8 (&q)[4]) {
    const int c8 = tid & 7, j0 = tid >> 3, kbase = 256 * u.nb - 128;
#pragma unroll
    for (int i = 0; i < 6; ++i) { if (u.nb > 0 || i >= 2) { const long l = kbase + j0 + 64 * i; kv[i] = *(const u32x4*)(u.kb + l * u.r * 64 + c8 * 8); vv[i] = *(const u32x4*)(u.vb + l * u.r * 64 + c8 * 8); } }
    const bf16_t* qp = u.qb + (size_t)(256 * u.nb + 32 * wave + (lane & 31)) * u.r * 64 + 8 * (lane >> 5);
#pragma unroll
    for (int d0 = 0; d0 < 4; ++d0) q[d0] = *(const bf16x8*)(qp + 16 * d0);
}
__device__ __forceinline__ void unit_fill(LAS unsigned char* lds, int nb, int tid, const u32x4 (&kv)[6], const u32x4 (&vv)[6]) {
    const int c8 = tid & 7, j0 = tid >> 3, key = j0 & 31;
    LAS unsigned char* kd = lds + KOFF + (j0 >> 5) * 4096 + key * 128 + ((c8 ^ ((key >> 1) & 7)) << 4);
    LAS unsigned char* vd = lds + VOFF + (c8 >> 2) * 4096 + j0 * 64 + (c8 & 3) * 16;
#pragma unroll
    for (int i = 0; i < 6; ++i) { if (nb > 0 || i >= 2) { *(LAS u32x4*)(kd + i * 8192) = kv[i]; *(LAS u32x4*)(vd + i * 8192) = vv[i]; } }
}
__device__ __forceinline__ void unit_compute(const Params& P, LAS unsigned char* lds, const UnitInfo& u, const bf16x8 (&qr)[4], int lane, int wave) {
    const int r32 = lane & 31, hi = lane >> 5, nb = u.nb;
    float mref = -INFINITY, l = 0.f; f32x16 o[2];
#pragma unroll
    for (int x = 0; x < 16; ++x) { o[0][x] = 0.f; o[1][x] = 0.f; }
    const int vlane = ((lane >> 4) & 1) * 32 + (lane & 3) * 8 + (4 * hi + ((lane & 15) >> 2)) * 64;
#pragma unroll
    for (int jt = 4; jt >= 0; --jt) {
        const int kt = wave + jt;
        if (nb == 0 && kt < 4) break;
        const LAS unsigned char* kb = lds + KOFF + kt * 4096 + r32 * 128;
        f32x16 p;
#pragma unroll
        for (int x = 0; x < 16; ++x) p[x] = 0.f;
#pragma unroll
        for (int d0 = 0; d0 < 4; ++d0) { const bf16x8 kf = *(const LAS bf16x8*)(kb + (((2 * d0 + hi) ^ ((r32 >> 1) & 7)) << 4)); p = __builtin_amdgcn_mfma_f32_32x32x16_bf16(kf, qr[d0], p, 0, 0, 0); }
        if (jt == 4) {
#pragma unroll
            for (int x = 0; x < 16; ++x) if (crow(x, hi) > r32) p[x] = -INFINITY;
        }
        if (jt == 0) {
#pragma unroll
            for (int x = 0; x < 16; ++x) if (crow(x, hi) < r32 + u.dm) p[x] = -INFINITY;
        }
        float tm = fmaxf(fmaxf(p[0], p[1]), p[2]);
#pragma unroll
        for (int x = 3; x < 15; x += 2) tm = fmaxf(fmaxf(tm, p[x]), p[x + 1]);
        tm = xmax(fmaxf(tm, p[15]));
        const float mn = fmaxf(mref, tm), al = __builtin_amdgcn_exp2f(mref - mn);
        mref = mn;
        float ls = 0.f;
#pragma unroll
        for (int x = 0; x < 16; ++x) { p[x] = __builtin_amdgcn_exp2f(p[x] - mn); ls += p[x]; }
        l = l * al + ls;
#pragma unroll
        for (int x = 0; x < 16; ++x) { o[0][x] *= al; o[1][x] *= al; }
        u32x4 pw[2];
#pragma unroll
        for (int s2 = 0; s2 < 2; ++s2) { pw[s2].x = cvtpk(p[8 * s2 + 0], p[8 * s2 + 1]); pw[s2].y = cvtpk(p[8 * s2 + 2], p[8 * s2 + 3]); pw[s2].z = cvtpk(p[8 * s2 + 4], p[8 * s2 + 5]); pw[s2].w = cvtpk(p[8 * s2 + 6], p[8 * s2 + 7]); }
        const LAS unsigned char* vb = lds + VOFF + (kt >> 1) * 8192 + (kt & 1) * 2048 + vlane;
#pragma unroll
        for (int d0 = 0; d0 < 2; ++d0)
#pragma unroll
            for (int s2 = 0; s2 < 2; ++s2) { const s16x4 lo = vtr(vb + d0 * 4096 + s2 * 1024), hh = vtr(vb + d0 * 4096 + s2 * 1024 + 512);
                const bf16x8 vf = (bf16x8){lo[0], lo[1], lo[2], lo[3], hh[0], hh[1], hh[2], hh[3]};
                o[d0] = __builtin_amdgcn_mfma_f32_32x32x16_bf16(vf, __builtin_bit_cast(bf16x8, pw[s2]), o[d0], 0, 0, 0); }
    }
    l = xsum(l);
    const size_t t = u.tok0 + (size_t)(256 * nb + 32 * wave + r32) * u.r;
    float inv; bf16_t* dst; size_t pitch;
    if (u.kind < 3) { inv = 1.0f / l; dst = (bf16_t*)(P.ws + WS_PART) + ((size_t)u.kind * NTOK + u.tok0 + (size_t)(256 * nb + 32 * wave) * u.r) * 512 + u.h * 64;
        if (hi == 0) ((float*)(P.ws + WS_LSE))[((size_t)u.kind * NTOK + t) * 8 + u.h] = mref + __builtin_amdgcn_logf(l); }
    else { inv = 1.0f / (l + __builtin_amdgcn_exp2f(P.sinks[u.h] * LOG2E - mref)); dst = (bf16_t*)(P.ws + WS_OSWA) + (u.tok0 + (size_t)(256 * nb + 32 * wave) * u.r) * 512 + u.h * 64; }
    pitch = (size_t)u.r * 512;
    LAS unsigned char* stg = lds + OOFF + wave * 4096;
#pragma unroll
    for (int d0 = 0; d0 < 2; ++d0)
#pragma unroll
        for (int g = 0; g < 4; ++g) { u32x2 w; w.x = cvtpk(o[d0][4 * g] * inv, o[d0][4 * g + 1] * inv); w.y = cvtpk(o[d0][4 * g + 2] * inv, o[d0][4 * g + 3] * inv);
            *(LAS u32x2*)(stg + r32 * 128 + (((4 * d0 + g) ^ (r32 & 7)) << 4) + 8 * hi) = w; }
#pragma unroll
    for (int i = 0; i < 4; ++i) { const int row = 8 * i + (lane >> 3), ch = lane & 7;
        const u32x4 v = *(const LAS u32x4*)(stg + row * 128 + ((ch ^ (row & 7)) << 4));
        *(u32x4*)(dst + (size_t)row * pitch + 8 * ch) = v; }
}
__device__ __forceinline__ int unit_of(int it, int wg, int G) {
    if (G != 256) return it * G + wg;
    const int x = wg & 7, y = wg >> 3;
    const int gl = 2 * it + (y >> 4), sub = y & 15;
    int kind, b, h;
    if (gl < 24) { kind = gl >> 3; b = gl & 7; h = x; } else { const int q = gl - 24; kind = 3; b = 4 * (q >> 2 & 1) + (x >> 1); h = 4 * (x & 1) + (q & 3); }
    return (kind << 10) | (b << 7) | (h << 4) | sub;
}
__device__ __forceinline__ void attn_phase(const Params& P, LAS unsigned char* lds, int tid, int lane, int wave) {
    const int G = gridDim.x, nit = (4096 + G - 1) / G; int it = 0;
    int unit = unit_of(0, blockIdx.x, G); if (unit >= 4096) return;
    UnitInfo cur = decode(P, unit);
    u32x4 kv[6], vv[6]; bf16x8 qn[4];
    unit_loads(cur, tid, lane, wave, kv, vv, qn);
    for (;;) {
        unit_fill(lds, cur.nb, tid, kv, vv);
        bf16x8 qr[4];
#pragma unroll
        for (int d0 = 0; d0 < 4; ++d0) qr[d0] = qn[d0];
        __syncthreads();
        const int nunit = (it + 1 < nit) ? unit_of(it + 1, blockIdx.x, G) : 4096; const bool has_next = nunit < 4096;
        UnitInfo nxt = cur;
        if (has_next) { nxt = decode(P, nunit); unit_loads(nxt, tid, lane, wave, kv, vv, qn); }
        unit_compute(P, lds, cur, qr, lane, wave);
        __syncthreads();
        if (!has_next) break;
        cur = nxt; unit = nunit; ++it;
    }
}
}

__device__ __forceinline__ void p2b_merge(const Params& P, int gw, int ngw, int lane) {
    unsigned char* ws = P.ws;
    const bf16_t* PART = (const bf16_t*)(ws + WS_PART); const bf16_t* OSWA = (const bf16_t*)(ws + WS_OSWA); const float* LSE = (const float*)(ws + WS_LSE);
    unsigned char* MIXED = ws + WS_MIXED;
    const f32x4 gda = *(const f32x4*)(P.gn_dil + lane * 8), gdb = *(const f32x4*)(P.gn_dil + lane * 8 + 4), gsa = *(const f32x4*)(P.gn_swa + lane * 8), gsb = *(const f32x4*)(P.gn_swa + lane * 8 + 4);
    const int h = lane >> 3;
    for (int t0 = 4 * gw; t0 < NTOK; t0 += 4 * ngw) {
        float ls[4][3]; u32x4 pv[4][3], sv[4];
#pragma unroll
        for (int q = 0; q < 4; ++q) { const int t = t0 + q;
#pragma unroll
            for (int c = 0; c < 3; ++c) { ls[q][c] = LSE[((size_t)c * NTOK + t) * 8 + h]; pv[q][c] = *(const u32x4*)(PART + ((size_t)c * NTOK + t) * 512 + lane * 8); }
            sv[q] = *(const u32x4*)(OSWA + (size_t)t * 512 + lane * 8); }
#pragma unroll
        for (int q = 0; q < 4; ++q) { const int t = t0 + q;
            const float mx = fmaxf(fmaxf(ls[q][0], ls[q][1]), ls[q][2]);
            float wsum = 0.f, w[3];
#pragma unroll
            for (int c = 0; c < 3; ++c) { w[c] = exp2f(ls[q][c] - mx); wsum += w[c]; }
            const float winv = 1.0f / wsum;
            float o[8];
#pragma unroll
            for (int i = 0; i < 8; ++i) o[i] = 0.f;
#pragma unroll
            for (int c = 0; c < 3; ++c) { const u32x4 v = pv[q][c]; const float wc = w[c] * winv;
                o[0] += wc * bflo(v.x); o[1] += wc * bfhi(v.x); o[2] += wc * bflo(v.y); o[3] += wc * bfhi(v.y);
                o[4] += wc * bflo(v.z); o[5] += wc * bfhi(v.z); o[6] += wc * bflo(v.w); o[7] += wc * bfhi(v.w); }
            float ss = 0.f;
#pragma unroll
            for (int i = 0; i < 8; ++i) ss += o[i] * o[i];
            float rstd = MIX_FP8_SCALE / sqrtf(wave_sum(ss) * (1.0f / 512.0f) + EPS);
            { u32x2 w2; w2.x = pk4_fp8(o[0] * rstd * gda.x, o[1] * rstd * gda.y, o[2] * rstd * gda.z, o[3] * rstd * gda.w);
              w2.y = pk4_fp8(o[4] * rstd * gdb.x, o[5] * rstd * gdb.y, o[6] * rstd * gdb.z, o[7] * rstd * gdb.w);
              *(u32x2*)(MIXED + (size_t)t * DM + lane * 8) = w2; }
            { const u32x4 v = sv[q];
              o[0] = bflo(v.x); o[1] = bfhi(v.x); o[2] = bflo(v.y); o[3] = bfhi(v.y); o[4] = bflo(v.z); o[5] = bfhi(v.z); o[6] = bflo(v.w); o[7] = bfhi(v.w); }
            ss = 0.f;
#pragma unroll
            for (int i = 0; i < 8; ++i) ss += o[i] * o[i];
            rstd = MIX_FP8_SCALE / sqrtf(wave_sum(ss) * (1.0f / 512.0f) + EPS);
            { u32x2 w2; w2.x = pk4_fp8(o[0] * rstd * gsa.x, o[1] * rstd * gsa.y, o[2] * rstd * gsa.z, o[3] * rstd * gsa.w);
              w2.y = pk4_fp8(o[4] * rstd * gsb.x, o[5] * rstd * gsb.y, o[6] * rstd * gsb.z, o[7] * rstd * gsb.w);
              *(u32x2*)(MIXED + (size_t)t * DM + 512 + lane * 8) = w2; }
        }
    }
}

namespace route {
constexpr int NWAVES_R = 8;
constexpr int R_W = 0;
constexpr int R_LCNT = 131072 + 1024;
constexpr int R_REC = R_LCNT + 256;
constexpr int R_G2 = 131072 + 10240;
constexpr int XPRE = 24;
__device__ __forceinline__ void merge4(float (&v)[4], int (&e)[4], const float (&pv)[4], const int (&pe)[4]) {
    float cv[8]; int ce[8];
#pragma unroll
    for (int k = 0; k < 4; ++k) { cv[k] = v[k]; ce[k] = e[k]; cv[4 + k] = pv[k]; ce[4 + k] = pe[k]; }
#pragma unroll
    for (int k = 0; k < 4; ++k) { float best = -INFINITY; int bi = 0, be = 0;
#pragma unroll
        for (int x = 0; x < 8; ++x) { const bool better = (cv[x] > best) || (cv[x] == best && ce[x] < be); if (better) { best = cv[x]; bi = x; be = ce[x]; } }
        v[k] = best; e[k] = be;
#pragma unroll
        for (int x = 0; x < 8; ++x) cv[x] = (x == bi) ? -INFINITY : cv[x]; }
}
typedef float rf32x2 __attribute__((ext_vector_type(2)));
typedef __bf16 rbf16x2 __attribute__((ext_vector_type(2)));
__device__ __forceinline__ unsigned cvtpk(float lo, float hi) { const rf32x2 v = {lo, hi}; return __builtin_bit_cast(unsigned, __builtin_convertvector(v, rbf16x2)); }
__device__ __forceinline__ void route_block(const Params& P, LAS unsigned char* lds, int tb, int tid, int lane, int wave, bool stage) {
    unsigned char* ws = P.ws;
    bf16_t* H2 = (bf16_t*)(ws + WS_H2);
    const int tk = lane & 15, fq = lane >> 4;
    const int t = tb * 128 + wave * 16 + tk;
    LAS unsigned* lcnt = (LAS unsigned*)(lds + R_LCNT);
    const bf16_t* xp = (const bf16_t*)(ws + WS_X1B) + (size_t)t * DM + 8 * fq;
    if (stage) {
        const u32x4* src = (const u32x4*)(P.ws + WS_WRH);
#pragma unroll 4
        for (int i = tid; i < 8192; i += NWAVES_R * 64) { const int half = i >> 12, e = (i >> 7) & 31, ch = i & 127;
            *(LAS u32x4*)(lds + R_W + half * 65536 + e * 2048 + ((ch ^ (e & 15)) << 4)) = src[i]; }
        if (tid < 256) *(LAS f32x4*)(lds + R_G2 + tid * 16) = *(const f32x4*)(P.g2 + tid * 4);
    }
    u32x4 xwv[32];
#pragma unroll
    for (int ks = 0; ks < XPRE; ++ks) xwv[ks] = *(const u32x4*)(xp + 32 * ks);
    if (tid < 64) lcnt[tid] = 0u;
    asm volatile("s_waitcnt vmcnt(0) lgkmcnt(0)" ::: "memory");
    __builtin_amdgcn_s_barrier();
    const LAS float* gp = (const LAS float*)(lds + R_G2) + 8 * fq;
    const LAS unsigned char* wrow = lds + R_W + tk * 2048;
    unsigned char* hp = (unsigned char*)H2 + (size_t)t * DM + 8 * fq;
    f32x4 d0 = {0.f, 0.f, 0.f, 0.f}, d1 = {0.f, 0.f, 0.f, 0.f};
    float ss = 0.f;
#pragma unroll
    for (int ks = 0; ks < 32; ++ks) {
        if (ks == 32 - XPRE) {
#pragma unroll
            for (int k2 = XPRE; k2 < 32; ++k2) xwv[k2] = *(const u32x4*)(xp + 32 * k2); }
        const u32x4 xw = xwv[ks]; const f32x4 xa = {bflo(xw.x), bfhi(xw.x), bflo(xw.y), bfhi(xw.y)}, xb = {bflo(xw.z), bfhi(xw.z), bflo(xw.w), bfhi(xw.w)}, ga = *(const LAS f32x4*)(gp + 32 * ks), gb = *(const LAS f32x4*)(gp + 32 * ks + 4);
        const int wo = ((4 * ks + fq) ^ tk) << 4;
        const bf16x8 ah0 = *(const LAS bf16x8*)(wrow + wo), al0 = *(const LAS bf16x8*)(wrow + 65536 + wo), ah1 = *(const LAS bf16x8*)(wrow + 32768 + wo), al1 = *(const LAS bf16x8*)(wrow + 98304 + wo);
        ss += (xa.x * xa.x + xa.y * xa.y) + (xa.z * xa.z + xa.w * xa.w) + (xb.x * xb.x + xb.y * xb.y) + (xb.z * xb.z + xb.w * xb.w);
        const f32x4 ha = xa * ga, hb = xb * gb;
        u32x4 bh, bl;
        bh.x = cvtpk(ha[0], ha[1]); bh.y = cvtpk(ha[2], ha[3]); bh.z = cvtpk(hb[0], hb[1]); bh.w = cvtpk(hb[2], hb[3]);
        bl.x = cvtpk(ha[0] - bflo(bh.x), ha[1] - bfhi(bh.x)); bl.y = cvtpk(ha[2] - bflo(bh.y), ha[3] - bfhi(bh.y)); bl.z = cvtpk(hb[0] - bflo(bh.z), hb[1] - bfhi(bh.z)); bl.w = cvtpk(hb[2] - bflo(bh.w), hb[3] - bfhi(bh.w));
        { u32x2 h8; h8.x = pk4_fp8(ha[0] * H2_FP8_SCALE, ha[1] * H2_FP8_SCALE, ha[2] * H2_FP8_SCALE, ha[3] * H2_FP8_SCALE); h8.y = pk4_fp8(hb[0] * H2_FP8_SCALE, hb[1] * H2_FP8_SCALE, hb[2] * H2_FP8_SCALE, hb[3] * H2_FP8_SCALE); *(u32x2*)(hp + 32 * ks) = h8; }
        const bf16x8 bhv = __builtin_bit_cast(bf16x8, bh), blv = __builtin_bit_cast(bf16x8, bl);
        d0 = __builtin_amdgcn_mfma_f32_16x16x32_bf16(ah0, bhv, d0, 0, 0, 0); d1 = __builtin_amdgcn_mfma_f32_16x16x32_bf16(ah1, bhv, d1, 0, 0, 0);
        d0 = __builtin_amdgcn_mfma_f32_16x16x32_bf16(al0, bhv, d0, 0, 0, 0); d1 = __builtin_amdgcn_mfma_f32_16x16x32_bf16(al1, bhv, d1, 0, 0, 0);
        d0 = __builtin_amdgcn_mfma_f32_16x16x32_bf16(ah0, blv, d0, 0, 0, 0); d1 = __builtin_amdgcn_mfma_f32_16x16x32_bf16(ah1, blv, d1, 0, 0, 0);
    }
    ss += __shfl_xor(ss, 16); ss += __shfl_xor(ss, 32);
    const float rstd = 1.0f / sqrtf(ss * (1.0f / DM) + EPS);
    float v[8]; int ve[8];
#pragma unroll
    for (int i = 0; i < 4; ++i) { ve[i] = 4 * fq + i; ve[4 + i] = 16 + 4 * fq + i; v[i] = d0[i] * rstd + P.b_router[ve[i]]; v[4 + i] = d1[i] * rstd + P.b_router[ve[4 + i]]; }
    float tv[4]; int te[4];
#pragma unroll
    for (int k = 0; k < 4; ++k) { float best = -INFINITY; int bi = 0;
#pragma unroll
        for (int x = 0; x < 8; ++x) if (v[x] > best) { best = v[x]; bi = x; }
        tv[k] = best; te[k] = (bi < 4) ? (4 * fq + bi) : (12 + 4 * fq + bi);
#pragma unroll
        for (int x = 0; x < 8; ++x) v[x] = (x == bi) ? -INFINITY : v[x]; }
#pragma unroll
    for (int rnd = 0; rnd < 2; ++rnd) { float pv[4]; int pe[4];
#pragma unroll
        for (int k = 0; k < 4; ++k) { pv[k] = __shfl_xor(tv[k], 16 << rnd); pe[k] = __shfl_xor(te[k], 16 << rnd); }
        merge4(tv, te, pv, pe); }
    float gate[4], sum = 0.f;
#pragma unroll
    for (int k = 0; k < 4; ++k) { gate[k] = __expf(tv[k] - tv[0]); sum += gate[k]; }
    const float rs = 1.0f / sum;
    if (fq == 0) {
#pragma unroll
        for (int k = 0; k < 4; ++k) { const unsigned rank = __hip_atomic_fetch_add(&lcnt[te[k]], 1u, __ATOMIC_RELAXED, __HIP_MEMORY_SCOPE_WORKGROUP);
            *(LAS u32x4*)(lds + R_REC + ((wave * 16 + tk) * 4 + k) * 16) = (u32x4){(unsigned)te[k], rank, __builtin_bit_cast(unsigned, gate[k] * rs), __builtin_bit_cast(unsigned, rstd)}; } }
    __syncthreads();
    if (tid < 32) { unsigned* cnt = (unsigned*)(ws + WS_CTL) + CW_CNT; const unsigned c = lcnt[tid]; lcnt[32 + tid] = c ? atomicAdd(cnt + tid, c) : 0u; }
    __syncthreads();
    { int* TOKL = (int*)(ws + WS_TOKL); int* ASSIGN = (int*)(ws + WS_ASSIGN); float* GATE = (float*)(ws + WS_GATE); float* RSL = (float*)(ws + WS_RSL);
      const u32x4 rec = *(const LAS u32x4*)(lds + R_REC + tid * 16);
      const int tt = tb * 128 + (tid >> 2); const unsigned e = rec.x, pos = lcnt[32 + e] + rec.y;
      const unsigned gbits = rec.z, rbits = rec.w;
      TOKL[e * NTOK + pos] = tt; RSL[e * NTOK + pos] = __builtin_bit_cast(float, rbits); ASSIGN[tt * 4 + (tid & 3)] = (int)((e << 16) | pos); GATE[tt * 4 + (tid & 3)] = __builtin_bit_cast(float, gbits); }
    __syncthreads();
}
__device__ __forceinline__ void route_phase(const Params& P, LAS unsigned char* lds, int tid, int lane, int wave) {
    if ((int)blockIdx.x >= NTOK / 128) return;
    for (int tb = blockIdx.x; tb < NTOK / 128; tb += gridDim.x) route_block(P, lds, tb, tid, lane, wave, tb == (int)blockIdx.x);
}
}

__device__ __forceinline__ void expert_tiles(const unsigned* cnt, int lane, int& my_cnt, int& my_tstart) {
    const int c = (int)__hip_atomic_load(cnt + (lane & 31), __ATOMIC_RELAXED, __HIP_MEMORY_SCOPE_AGENT);
    const int tl = (c + 255) >> 8; int inc = tl;
#pragma unroll
    for (int o = 1; o < 32; o <<= 1) { const int up = __shfl_up(inc, o, 32); if ((lane & 31) >= o) inc += up; }
    my_cnt = c; my_tstart = inc - tl;
}

__device__ __forceinline__ void p7_combine(const Params& P, int gw, int ngw, int lane, float* dstbase) {
    typedef float f32x2 __attribute__((ext_vector_type(2)));
    unsigned char* ws = P.ws;
    const unsigned char* Y = (const unsigned char*)(ws + WS_Y); const u32x4* ASSIGN = (const u32x4*)(ws + WS_ASSIGN); const f32x4* GATE = (const f32x4*)(ws + WS_GATE);
    const unsigned* cnt = (const unsigned*)(ws + WS_CTL) + CW_CNT;
    int mycnt, myts; expert_tiles(cnt, lane, mycnt, myts);
    f32x4 gf4[4];
#pragma unroll
    for (int j = 0; j < 4; ++j) gf4[j] = *((const f32x4*)P.gf + 4 * lane + j);
    int t0 = 2 * gw; if (t0 >= NTOK) return;
    u32x4 an[2]; f32x4 gn[2];
#pragma unroll
    for (int q = 0; q < 2; ++q) { an[q] = ASSIGN[t0 + q]; gn[q] = GATE[t0 + q]; }
    for (; t0 < NTOK; t0 += 2 * ngw) {
        u32x4 a[2]; f32x4 g[2];
#pragma unroll
        for (int q = 0; q < 2; ++q) { a[q] = an[q]; g[q] = gn[q]; }
        const int tn = (t0 + 2 * ngw < NTOK) ? t0 + 2 * ngw : t0;
#pragma unroll
        for (int q = 0; q < 2; ++q) { an[q] = ASSIGN[tn + q]; gn[q] = GATE[tn + q]; }
        u32x4 yv[2][4], xa[2], xb[2];
#pragma unroll
        for (int q = 0; q < 2; ++q) { const u32x4* xr = (const u32x4*)((const bf16_t*)(ws + WS_X1B) + (size_t)(t0 + q) * DM) + 2 * lane; xa[q] = xr[0]; xb[q] = xr[1];
            const unsigned aw[4] = {a[q].x, a[q].y, a[q].z, a[q].w};
#pragma unroll
            for (int k = 0; k < 4; ++k) { const int e = (int)(aw[k] >> 16), pos = (int)(aw[k] & 0xffffu); const int ts = __shfl(myts, e); yv[q][k] = __builtin_nontemporal_load((const u32x4*)(Y + ((size_t)ts * 256 + pos) * DM) + lane); } }
#pragma unroll
        for (int q = 0; q < 2; ++q) {
            f32x4 v[4];
            v[0] = (f32x4){bflo(xa[q].x), bfhi(xa[q].x), bflo(xa[q].y), bfhi(xa[q].y)}; v[1] = (f32x4){bflo(xa[q].z), bfhi(xa[q].z), bflo(xa[q].w), bfhi(xa[q].w)};
            v[2] = (f32x4){bflo(xb[q].x), bfhi(xb[q].x), bflo(xb[q].y), bfhi(xb[q].y)}; v[3] = (f32x4){bflo(xb[q].z), bfhi(xb[q].z), bflo(xb[q].w), bfhi(xb[q].w)};
            const float gk[4] = {g[q].x * (1.0f / Y_FP8_SCALE), g[q].y * (1.0f / Y_FP8_SCALE), g[q].z * (1.0f / Y_FP8_SCALE), g[q].w * (1.0f / Y_FP8_SCALE)};
#pragma unroll
            for (int k = 0; k < 4; ++k) { const unsigned yw[4] = {yv[q][k].x, yv[q][k].y, yv[q][k].z, yv[q][k].w};
#pragma unroll
                for (int j = 0; j < 4; ++j) { const f32x2 lo = __builtin_amdgcn_cvt_pk_f32_fp8((int)yw[j], false), hi = __builtin_amdgcn_cvt_pk_f32_fp8((int)yw[j], true);
                    v[j].x += gk[k] * lo.x; v[j].y += gk[k] * lo.y; v[j].z += gk[k] * hi.x; v[j].w += gk[k] * hi.y; } }
            float ss = 0.f;
#pragma unroll
            for (int j = 0; j < 4; ++j) ss += (v[j].x * v[j].x + v[j].y * v[j].y) + (v[j].z * v[j].z + v[j].w * v[j].w);
            const float rstd = 1.0f / sqrtf(wave_sum(ss) * (1.0f / DM) + EPS);
            f32x4* dr = (f32x4*)(dstbase + (size_t)(t0 + q) * DM) + 4 * lane;
#pragma unroll
            for (int j = 0; j < 4; ++j) dr[j] = v[j] * rstd * gf4[j];
        }
    }
}

namespace pg8 {
constexpr int BM = 256, BK = 64, HALF = 128, HTB = HALF * BK * 2, STAGE_BYTES = 8 * HTB, NXCD = 8, WGM = 8;
constexpr int EPI_SLOT_OFF = 131072 + 10240 + 512;
__host__ __device__ __forceinline__ int lds_byte(int r, int c) { const int st = (r >> 4) * 2 + (c >> 5), rr = r & 15, cc = c & 31, ob = rr * 64 + cc * 2; return st * 1024 + (ob ^ (((ob >> 9) & 1) << 5)); }
__host__ __device__ __forceinline__ void stage_rc(int b, int& R, int& C) { const int st = b / 1024, sb = b % 1024, swz = sb ^ (((sb >> 9) & 1) << 5); R = (st >> 1) * 16 + swz / 64; C = (st & 1) * 32 + (swz % 64) / 2; }
__host__ __device__ __forceinline__ int perm32(int rho) { const int n = rho >> 4, i = rho & 15; return 8 * (i >> 2) + 4 * n + (i & 3); }
struct Unit { int pm, pn, e, rt; };

__device__ __forceinline__ bool tile_order(int i, int G, int c, int nM, int nN, int& pm, int& pn) {
    const int nwg = nM * nN; const long L = (long)i * G + c; if (L >= nwg) return false;
    int wgid = (int)L; { const int q = nwg / NXCD, r = nwg % NXCD, xcd = wgid % NXCD, off = wgid / NXCD; wgid = (xcd < r ? xcd * (q + 1) : r * (q + 1) + (xcd - r) * q) + off; }
    const int nig = WGM * nN, gid = wgid / nig, fm = gid * WGM, gsz = (nM - fm) < WGM ? (nM - fm) : WGM;
    pm = fm + ((wgid % nig) % gsz); pn = (wgid % nig) / gsz; return true;
}
struct DenseOrder {
    const char* A; const char* Bt; int nM, nN, G, c; size_t tstep;
    __device__ __forceinline__ void init(const void* A_, const void* Bt_, int M, int N, int KB, int G_, int c_) { A = (const char*)A_; Bt = (const char*)Bt_; nM = M / BM; nN = N / BM; G = G_; c = c_; tstep = (size_t)BM * KB; }
    __device__ __forceinline__ bool next(int i, Unit& u) const { u.e = 0; u.rt = 0; return tile_order(i, G, c, nM, nN, u.pm, u.pn); }
    __device__ __forceinline__ const char* a_base(const Unit& u) const { return A + (size_t)u.pm * tstep; }
    __device__ __forceinline__ const char* b_base(const Unit& u) const { return Bt + (size_t)u.pn * tstep; }
    __device__ __forceinline__ void a_rows(const Unit&, unsigned (&)[2][2]) const {}
    __device__ __forceinline__ void a_rows_stage(const Unit&, LAS unsigned char*, int, int) const {}
    __device__ __forceinline__ void a_rows_lds(const Unit&, const LAS unsigned char*, unsigned (&)[2][2]) const {}
};
struct GroupedOrder {
    const char* A; const char* Bt; const int* tokl; const LAS int* tab; int NT, nN, G, c, KA, KB; size_t bexp;
    __device__ __forceinline__ bool next(int i, Unit& u) const {
        if (!tile_order(i, G, c, NT, nN, u.pm, u.pn)) return false;
        const int ts = tab[threadIdx.x & 31];
        const unsigned long long bal = __ballot(ts <= u.pm);
        const int e = __builtin_popcount((unsigned)bal) - 1;
        u.e = __builtin_amdgcn_readfirstlane(e); u.rt = u.pm - __builtin_amdgcn_readfirstlane(tab[u.e]); return true;
    }
    __device__ __forceinline__ const char* a_base(const Unit& u) const { return tokl ? A : A + (size_t)u.pm * BM * KA; }
    __device__ __forceinline__ const char* b_base(const Unit& u) const { return Bt + (size_t)u.e * bexp + (size_t)u.pn * BM * KB; }
    __device__ __forceinline__ void a_rows(const Unit& u, unsigned (&gv)[2][2]) const {
        const int ce = __builtin_amdgcn_readfirstlane(tab[32 + u.e]);
#pragma unroll
        for (int h = 0; h < 2; ++h)
#pragma unroll
            for (int i = 0; i < 2; ++i) { int R, C; stage_rc((int)threadIdx.x * 16 + i * 8192, R, C);
                const int pos = u.rt * BM + h * HALF + R; const int tok = pos < ce ? tokl[u.e * NTOK + pos] : 0; gv[h][i] = (unsigned)tok * (unsigned)KA + (unsigned)(C * 2); }
    }
    __device__ __forceinline__ void a_rows_stage(const Unit& u, LAS unsigned char* slot, int wid, int lane) const {
        if (wid == 2) __builtin_amdgcn_global_load_lds((const unsigned*)(tokl + (size_t)u.e * NTOK + u.rt * BM + 4 * lane), (LAS unsigned*)slot, 16, 0, 0);
    }
    __device__ __forceinline__ void a_rows_lds(const Unit& u, const LAS unsigned char* slot, unsigned (&gv)[2][2]) const {
        const int ce = __builtin_amdgcn_readfirstlane(tab[32 + u.e]);
#pragma unroll
        for (int h = 0; h < 2; ++h)
#pragma unroll
            for (int i = 0; i < 2; ++i) { int R, C; stage_rc((int)threadIdx.x * 16 + i * 8192, R, C);
                const int pl = h * HALF + R; const int tv = ((const LAS int*)slot)[pl]; const int tok = (u.rt * BM + pl) < ce ? tv : 0; gv[h][i] = (unsigned)tok * (unsigned)KA + (unsigned)(C * 2); }
    }
};

__device__ __forceinline__ unsigned cvt_pk_bf16(float lo, float hi) { unsigned r; asm volatile("v_cvt_pk_bf16_f32 %0, %1, %2" : "=v"(r) : "v"(lo), "v"(hi)); return r; }

typedef int v8i32 __attribute__((ext_vector_type(8)));
typedef unsigned u32x8 __attribute__((ext_vector_type(8)));
template <bool GATHER, bool FP8, class Epi, class Sched, bool ALIGN_EPI>
__device__ __forceinline__ void gemm_phase(LAS unsigned char* lds, const int KB, const Sched& S, const Epi& E) {
    const int tid = threadIdx.x, wid = __builtin_amdgcn_readfirstlane(tid >> 6), lane = tid & 63, wr = wid >> 2, wc = wid & 3, fr = lane & 15, fq = lane >> 4;
    const int nt = KB / 128;
    unsigned voffA[2], voffB[2];
#pragma unroll
    for (int i = 0; i < 2; ++i) { int R, C; stage_rc(tid * 16 + i * 8192, R, C);
        const int Rb = (int)Epi::PERM == 3 ? (64 * (R >> 5) + 16 * ((R & 15) >> 2) + 4 * ((R >> 4) & 1) + (((R & 1) << 1) | ((R >> 1) & 1))) : (int)Epi::PERM == 2 ? (64 * (R >> 5) + 16 * ((R & 15) >> 2) + 4 * ((R >> 4) & 1) + (R & 3)) : (int)Epi::PERM == 1 ? ((R & ~31) + perm32(R & 31)) : R;
        voffA[i] = (unsigned)(R * KB + C * 2); voffB[i] = (unsigned)(Rb * KB + C * 2); }
    const size_t kstep = (size_t)(BK * 2);
    const size_t hstep = (size_t)HALF * KB;
    const size_t hstepA = GATHER ? (size_t)0 : hstep;
    const size_t hstepB = (int)Epi::PERM >= 2 ? (size_t)8 * KB : hstep;
    const unsigned ldsw = (unsigned)wid * 1024u;
    const int aoff = lds_byte(wr * 64 + fr, fq * 8), boff = lds_byte(wc * 32 + fr, fq * 8);
#define PG8_SA(b, h) (((b) * 2 + (h)) * HTB)
#define PG8_SB(b, h) ((4 + (b) * 2 + (h)) * HTB)
#define PG8_STAGE(bufoff, gbase, voff) do { _Pragma("unroll") for (int _i = 0; _i < 2; ++_i) \
        __builtin_amdgcn_global_load_lds((const unsigned*)((const char*)(gbase) + (voff)[_i]), (LAS unsigned*)(lds + (bufoff) + ldsw + _i * 8192), 16, 0, 0); } while (0)
#define PG8_STAGE_A(bufoff, gbase, h, gvsel) do { if constexpr (GATHER) { PG8_STAGE(bufoff, gbase, gvsel[h]); } else { PG8_STAGE(bufoff, gbase, voffA); } } while (0)
#define PG8_LD32(addr) (u32x8)__builtin_shufflevector(*(const LAS u32x4*)(addr), *(const LAS u32x4*)((addr) + 1024), 0, 1, 2, 3, 4, 5, 6, 7)
#define PG8_LDA(dst, b, h) do { if constexpr (FP8) { _Pragma("unroll") for (int m = 0; m < 4; ++m) dst##8[m] = PG8_LD32(lds + PG8_SA(b, h) + aoff + m * 2048); } \
    else { _Pragma("unroll") for (int m = 0; m < 4; ++m) _Pragma("unroll") for (int k = 0; k < 2; ++k) dst[m][k] = *(const LAS bf16x8*)(lds + PG8_SA(b, h) + aoff + m * 2048 + k * 1024); } } while (0)
#define PG8_LDB(dst, b, h) do { if constexpr (FP8) { _Pragma("unroll") for (int n = 0; n < 2; ++n) dst##8[n] = PG8_LD32(lds + PG8_SB(b, h) + boff + n * 2048); } \
    else { _Pragma("unroll") for (int n = 0; n < 2; ++n) _Pragma("unroll") for (int k = 0; k < 2; ++k) dst[n][k] = *(const LAS bf16x8*)(lds + PG8_SB(b, h) + boff + n * 2048 + k * 1024); } } while (0)
#define PG8_MMA(ai, bj, At, Bt) do { __builtin_amdgcn_s_setprio(1); if constexpr (FP8) { _Pragma("unroll") for (int m = 0; m < 4; ++m) _Pragma("unroll") for (int n = 0; n < 2; ++n) \
        asm volatile("v_mfma_f32_16x16x128_f8f6f4 %0, %1, %2, %0" : "+v"(acc[ai][bj][m][n]) : "v"(Bt##8[n]), "v"(At##8[m])); } \
    else { _Pragma("unroll") for (int m = 0; m < 4; ++m) _Pragma("unroll") for (int n = 0; n < 2; ++n) _Pragma("unroll") for (int k = 0; k < 2; ++k) \
        acc[ai][bj][m][n] = __builtin_amdgcn_mfma_f32_16x16x32_bf16(Bt[n][k], At[m][k], acc[ai][bj][m][n], 0, 0, 0); } __builtin_amdgcn_s_setprio(0); } while (0)
#define PG8_MMAZ(ai, bj, At, Bt, z) do { if constexpr (FP8) { if (z) { __builtin_amdgcn_s_setprio(1); _Pragma("unroll") for (int m = 0; m < 4; ++m) _Pragma("unroll") for (int n = 0; n < 2; ++n) \
        asm volatile("v_mfma_f32_16x16x128_f8f6f4 %0, %1, %2, 0" : "=&v"(acc[ai][bj][m][n]) : "v"(Bt##8[n]), "v"(At##8[m])); __builtin_amdgcn_s_setprio(0); } else PG8_MMA(ai, bj, At, Bt); } else PG8_MMA(ai, bj, At, Bt); } while (0)
#define PG8_WAIT_V(n) asm volatile("s_waitcnt vmcnt(" #n ")" ::: "memory")
#define PG8_WAIT_L(n) asm volatile("s_waitcnt lgkmcnt(" #n ")" ::: "memory")
#define PG8_BAR __builtin_amdgcn_s_barrier()
#define PG8_SCHED __builtin_amdgcn_sched_barrier(0)
    Unit cur, nxt; int ui = 0;
    if (!S.next(0, cur)) return;
    f32x4 acc[2][2][4][2];
    if constexpr (!FP8) {
#pragma unroll
    for (int a = 0; a < 2; ++a)
#pragma unroll
        for (int b = 0; b < 2; ++b)
#pragma unroll
            for (int m = 0; m < 4; ++m)
#pragma unroll
                for (int n = 0; n < 2; ++n) acc[a][b][m][n] = (f32x4){0.f, 0.f, 0.f, 0.f};
    }
    bf16x8 At[4][2], B0[2][2], B1[2][2]; u32x8 At8[4], B08[2], B18[2];
    const char* cA = S.a_base(cur); const char* cB = S.b_base(cur);
    unsigned gvc[2][2] = {{0u, 0u}, {0u, 0u}};
    LAS unsigned char* tslot = lds + EPI_SLOT_OFF + 4096;
    if constexpr (GATHER) S.a_rows(cur, gvc);
    PG8_STAGE(PG8_SB(0, 0), cB, voffB); PG8_STAGE(PG8_SB(0, 1), cB + hstepB, voffB); PG8_STAGE_A(PG8_SA(0, 0), cA, 0, gvc); PG8_STAGE_A(PG8_SA(0, 1), cA + hstepA, 1, gvc);
    if (wr == 1) PG8_BAR;
    PG8_WAIT_V(2); PG8_BAR;
    PG8_STAGE(PG8_SB(1, 0), cB + kstep, voffB); PG8_STAGE_A(PG8_SA(1, 0), cA + kstep, 0, gvc); PG8_STAGE(PG8_SB(1, 1), cB + hstepB + kstep, voffB);
    PG8_WAIT_V(6); PG8_BAR;
    for (;;) {
        const bool has_next = S.next(ui + 1, nxt);
        const char* nA = has_next ? S.a_base(nxt) : cA; const char* nB = has_next ? S.b_base(nxt) : cB;
        if constexpr (GATHER) { if (has_next) S.a_rows_stage(nxt, tslot, wid, lane); }
        LAS unsigned char* eslot = lds + EPI_SLOT_OFF + (ui & 1) * 2048;
        E.stage(cur, eslot, wid, lane);
#pragma unroll 1
        for (int t = 0; t < nt; t += 2) {
            const bool last = (t == nt - 2), first = (t == 0);
            const char* a1 = cA + (size_t)(t + 1) * kstep;
            const char* a2 = last ? nA : cA + (size_t)(t + 2) * kstep; const char* b2 = last ? nB : cB + (size_t)(t + 2) * kstep;
            const char* a3 = a2 + kstep; const char* b3 = b2 + kstep;
            PG8_LDB(B0, 0, 0); PG8_LDB(B1, 0, 1); PG8_SCHED; PG8_LDA(At, 0, 0); PG8_STAGE_A(PG8_SA(1, 1), a1 + hstepA, 1, gvc);
            if constexpr (GATHER) { if (last && has_next) S.a_rows_lds(nxt, tslot, gvc); }
            PG8_WAIT_V(8); PG8_WAIT_L(0); PG8_BAR; PG8_MMAZ(0, 0, At, B0, first); PG8_MMAZ(0, 1, At, B1, first); PG8_BAR; PG8_SCHED;
            PG8_LDA(At, 0, 1); PG8_STAGE(PG8_SB(0, 0), b2, voffB); PG8_STAGE(PG8_SB(0, 1), b2 + hstepB, voffB); PG8_STAGE_A(PG8_SA(0, 0), a2, 0, gvc);
            PG8_WAIT_V(8); PG8_WAIT_L(0); PG8_BAR; PG8_MMAZ(1, 0, At, B0, first); PG8_MMAZ(1, 1, At, B1, first); PG8_BAR; PG8_SCHED;
            PG8_LDB(B0, 1, 0); PG8_LDB(B1, 1, 1); PG8_SCHED; PG8_LDA(At, 1, 0); PG8_STAGE_A(PG8_SA(0, 1), a2 + hstepA, 1, gvc);
            PG8_WAIT_V(8); PG8_WAIT_L(0); PG8_BAR; PG8_MMA(0, 0, At, B0); PG8_MMA(0, 1, At, B1); PG8_BAR; PG8_SCHED;
            PG8_LDA(At, 1, 1); PG8_STAGE(PG8_SB(1, 0), b3, voffB); PG8_STAGE(PG8_SB(1, 1), b3 + hstepB, voffB); PG8_STAGE_A(PG8_SA(1, 0), a3, 0, gvc);
            PG8_WAIT_V(8); PG8_WAIT_L(0); PG8_BAR; PG8_MMA(1, 0, At, B0); PG8_MMA(1, 1, At, B1); PG8_BAR; PG8_SCHED;
        }
        if constexpr (ALIGN_EPI) { if (wr == 0) PG8_BAR; }
        if constexpr (FP8) asm volatile("s_nop 15\n\ts_nop 15" ::: "memory");
        E(acc, cur, wr, wc, fr, fq, eslot);
        if (!has_next) break;
        if constexpr (!FP8)
#pragma unroll
        for (int a = 0; a < 2; ++a)
#pragma unroll
            for (int b = 0; b < 2; ++b)
#pragma unroll
                for (int m = 0; m < 4; ++m)
#pragma unroll
                    for (int n = 0; n < 2; ++n) acc[a][b][m][n] = (f32x4){0.f, 0.f, 0.f, 0.f};
        cur = nxt; cA = nA; cB = nB; ++ui;
        if constexpr (ALIGN_EPI) { if (wr == 1) PG8_BAR; }
    }
    PG8_WAIT_V(0);
    if constexpr (!ALIGN_EPI) { if (wr == 0) PG8_BAR; }
    PG8_BAR;
#undef PG8_SA
#undef PG8_SB
#undef PG8_STAGE
#undef PG8_STAGE_A
#undef PG8_LDA
#undef PG8_LDB
#undef PG8_MMA
#undef PG8_MMAZ
#undef PG8_LD32
#undef PG8_WAIT_V
#undef PG8_WAIT_L
#undef PG8_BAR
#undef PG8_SCHED
}

struct EpiQKV {
    static constexpr int PERM = 1;
    bf16_t* QKV; const float* bias; const float* RC; const float* RS;
    __device__ __forceinline__ void stage(const Unit&, LAS unsigned char*, int, int) const {}
    __device__ __forceinline__ void operator()(const f32x4 (&acc)[2][2][4][2], const Unit& u, int wr, int wc, int fr, int fq, const LAS unsigned char*) const {
        const int hs = u.pn * 4 + wc; const bool rope = (hs < 16) || (hs >= 24 && hs < 34); const float sc = (hs < 8 || (hs >= 24 && hs < 32)) ? QSCALE : 1.0f;
        f32x4 bv[2][2];
#pragma unroll
        for (int bj = 0; bj < 2; ++bj)
#pragma unroll
            for (int n = 0; n < 2; ++n) bv[bj][n] = *(const f32x4*)(bias + hs * 64 + 32 * bj + 8 * fq + 4 * n);
#pragma unroll
        for (int ai = 0; ai < 2; ++ai) {
            f32x4 cs[4][2], sn[4][2];
#pragma unroll
            for (int m = 0; m < 4; ++m) { const size_t t = (size_t)(u.pm * BM + ai * HALF + wr * 64 + m * 16 + fr);
#pragma unroll
                for (int n = 0; n < 2; ++n) { if (rope) { cs[m][n] = *(const f32x4*)(RC + t * 32 + 8 * fq + 4 * n); sn[m][n] = *(const f32x4*)(RS + t * 32 + 8 * fq + 4 * n); }
                    else { cs[m][n] = (f32x4){1.f, 1.f, 1.f, 1.f}; sn[m][n] = (f32x4){0.f, 0.f, 0.f, 0.f}; } } }
            asm volatile("" ::: "memory");
#pragma unroll
            for (int m = 0; m < 4; ++m) { const int t = u.pm * BM + ai * HALF + wr * 64 + m * 16 + fr;
                f32x4 o1[2], o2[2];
#pragma unroll
                for (int n = 0; n < 2; ++n) { const f32x4 v1 = acc[ai][0][m][n] + bv[0][n], v2 = acc[ai][1][m][n] + bv[1][n];
                    o1[n] = (v1 * cs[m][n] - v2 * sn[m][n]) * sc; o2[n] = (v2 * cs[m][n] + v1 * sn[m][n]) * sc; }
                bf16_t* dst = QKV + ((size_t)hs * NTOK + t) * 64 + 8 * fq;
                u32x4 w1, w2; w1.x = cvt_pk_bf16(o1[0][0], o1[0][1]); w1.y = cvt_pk_bf16(o1[0][2], o1[0][3]); w1.z = cvt_pk_bf16(o1[1][0], o1[1][1]); w1.w = cvt_pk_bf16(o1[1][2], o1[1][3]);
                w2.x = cvt_pk_bf16(o2[0][0], o2[0][1]); w2.y = cvt_pk_bf16(o2[0][2], o2[0][3]); w2.z = cvt_pk_bf16(o2[1][0], o2[1][1]); w2.w = cvt_pk_bf16(o2[1][2], o2[1][3]);
                *(u32x4*)dst = w1; *(u32x4*)(dst + 32) = w2; }
        }
    }
};
struct EpiOut {
    static constexpr int PERM = 1;
    const bf16_t* h1; const float* sr1; const float* g1; bf16_t* x1b; const float* bias; float oscale;
    __device__ __forceinline__ void stage(const Unit& u, LAS unsigned char* slot, int wid, int lane) const {
        if (wid == 0) __builtin_amdgcn_global_load_lds((const unsigned*)(sr1 + u.pm * BM + 4 * lane), (LAS unsigned*)slot, 16, 0, 0);
    }
    __device__ __forceinline__ void operator()(const f32x4 (&acc)[2][2][4][2], const Unit& u, int wr, int wc, int fr, int fq, const LAS unsigned char* slot) const {
        const int col0 = u.pn * BM + wc * 32 + 8 * fq;
        const LAS float* srp = (const LAS float*)slot + wr * 64 + fr;
        f32x4 bv[2][2], gi[2][2];
#pragma unroll
        for (int bj = 0; bj < 2; ++bj)
#pragma unroll
            for (int n = 0; n < 2; ++n) { bv[bj][n] = *(const f32x4*)(bias + col0 + bj * HALF + 4 * n); const f32x4 g = *(const f32x4*)(g1 + col0 + bj * HALF + 4 * n);
                gi[bj][n] = (f32x4){__builtin_amdgcn_rcpf(g[0]), __builtin_amdgcn_rcpf(g[1]), __builtin_amdgcn_rcpf(g[2]), __builtin_amdgcn_rcpf(g[3])}; }
#pragma unroll
        for (int ai = 0; ai < 2; ++ai) {
            u32x4 hv[4][2];
#pragma unroll
            for (int m = 0; m < 4; ++m) { const size_t off = (size_t)(u.pm * BM + ai * HALF + wr * 64 + m * 16 + fr) * DM + col0;
#pragma unroll
                for (int bj = 0; bj < 2; ++bj) hv[m][bj] = __builtin_nontemporal_load((const u32x4*)(h1 + off + bj * HALF)); }
            asm volatile("" ::: "memory");
#pragma unroll
            for (int m = 0; m < 4; ++m) { const size_t off = (size_t)(u.pm * BM + ai * HALF + wr * 64 + m * 16 + fr) * DM + col0; const float sr = srp[ai * HALF + m * 16];
#pragma unroll
                for (int bj = 0; bj < 2; ++bj) { const u32x4 h = hv[m][bj];
                    const f32x4 x0 = (f32x4){bflo(h.x), bfhi(h.x), bflo(h.y), bfhi(h.y)} * (gi[bj][0] * sr), x1 = (f32x4){bflo(h.z), bfhi(h.z), bflo(h.w), bfhi(h.w)} * (gi[bj][1] * sr);
                    const f32x4 v0 = x0 + acc[ai][bj][m][0] * oscale + bv[bj][0], v1 = x1 + acc[ai][bj][m][1] * oscale + bv[bj][1];
                    u32x4 w; w.x = cvt_pk_bf16(v0[0], v0[1]); w.y = cvt_pk_bf16(v0[2], v0[3]); w.z = cvt_pk_bf16(v1[0], v1[1]); w.w = cvt_pk_bf16(v1[2], v1[3]);
                    *(u32x4*)(x1b + off + bj * HALF) = w; } }
        }
    }
};
typedef float f32x2 __attribute__((ext_vector_type(2)));
struct EpiSwiglu {
    static constexpr int PERM = 3;
    unsigned char* HID; const float* b1; const float* rsl; float oscale;
    __device__ __forceinline__ void stage(const Unit& u, LAS unsigned char* slot, int wid, int lane) const {
        if (wid == 0) __builtin_amdgcn_global_load_lds((const unsigned*)(b1 + (size_t)u.e * DU + u.pn * BM + 4 * lane), (LAS unsigned*)slot, 16, 0, 0);
        if (wid == 1) __builtin_amdgcn_global_load_lds((const unsigned*)(rsl + (size_t)u.e * NTOK + u.rt * BM + 4 * lane), (LAS unsigned*)(slot + 1024), 16, 0, 0);
    }
    __device__ __forceinline__ void operator()(const f32x4 (&acc)[2][2][4][2], const Unit& u, int wr, int wc, int fr, int fq, const LAS unsigned char* slot) const {
        const int uc0 = u.pn * BM + wc * 64 + 16 * fq;
        const LAS float* bsl = (const LAS float*)slot + wc * 64 + 16 * fq; const LAS float* rsp = (const LAS float*)(slot + 1024) + wr * 64 + fr;
        f32x4 bv[2][2];
#pragma unroll
        for (int bj = 0; bj < 2; ++bj)
#pragma unroll
            for (int n = 0; n < 2; ++n) { const f32x4 b = *(const LAS f32x4*)(bsl + 8 * bj + 4 * n); bv[bj][n] = (f32x4){b[0], b[2], __builtin_fmaf(b[1], HID_FP8_SCALE, HID_FP8_SCALE), __builtin_fmaf(b[3], HID_FP8_SCALE, HID_FP8_SCALE)}; }
#pragma unroll
        for (int ai = 0; ai < 2; ++ai)
#pragma unroll
            for (int m = 0; m < 4; ++m) { f32x2 hv[4]; const float rs = rsp[ai * HALF + m * 16] * oscale, rss = rs * HID_FP8_SCALE; const f32x4 rs4 = (f32x4){rs, rs, rss, rss};
#pragma unroll
                for (int bj = 0; bj < 2; ++bj)
#pragma unroll
                    for (int n = 0; n < 2; ++n) { const f32x4 v = acc[ai][bj][m][n] * rs4 + bv[bj][n];
                        const f32x2 g = (f32x2){fminf(v[0], 7.0f), fminf(v[1], 7.0f)};
                        const f32x2 l = (f32x2){__builtin_amdgcn_fmed3f(v[2], -6.0f * HID_FP8_SCALE, 8.0f * HID_FP8_SCALE), __builtin_amdgcn_fmed3f(v[3], -6.0f * HID_FP8_SCALE, 8.0f * HID_FP8_SCALE)};
                        const f32x2 t = g * (-1.702f * LOG2E);
                        const f32x2 d = (f32x2){__builtin_amdgcn_exp2f(t[0]), __builtin_amdgcn_exp2f(t[1])} + 1.0f;
                        const f32x2 r = (f32x2){__builtin_amdgcn_rcpf(d[0]), __builtin_amdgcn_rcpf(d[1])};
                        hv[2 * bj + n] = (g * r) * l; }
                u32x2 w; w.x = pk4_fp8(hv[0][0], hv[0][1], hv[1][0], hv[1][1]); w.y = pk4_fp8(hv[2][0], hv[2][1], hv[3][0], hv[3][1]);
                *(u32x2*)(HID + (size_t)(u.pm * BM + ai * HALF + wr * 64 + m * 16 + fr) * DFF + (uc0 >> 1)) = w; }
    }
};
struct EpiY {
    static constexpr int PERM = 2;
    unsigned char* Y; const float* b2; float oscale;
    __device__ __forceinline__ void stage(const Unit& u, LAS unsigned char* slot, int wid, int lane) const {
        if (wid == 0) __builtin_amdgcn_global_load_lds((const unsigned*)(b2 + (size_t)u.e * DM + u.pn * BM + 4 * lane), (LAS unsigned*)slot, 16, 0, 0);
    }
    __device__ __forceinline__ void operator()(const f32x4 (&acc)[2][2][4][2], const Unit& u, int wr, int wc, int fr, int fq, const LAS unsigned char* slot) const {
        const int col0 = u.pn * BM + wc * 64 + 16 * fq;
        const LAS float* bsl = (const LAS float*)slot + wc * 64 + 16 * fq;
        f32x4 bv[2][2];
#pragma unroll
        for (int bj = 0; bj < 2; ++bj)
#pragma unroll
            for (int n = 0; n < 2; ++n) bv[bj][n] = *(const LAS f32x4*)(bsl + 8 * bj + 4 * n) * Y_FP8_SCALE;
        const float os = oscale * Y_FP8_SCALE;
#pragma unroll
        for (int ai = 0; ai < 2; ++ai)
#pragma unroll
            for (int m = 0; m < 4; ++m) { u32x4 w;
                { const f32x4 v = acc[ai][0][m][0] * os + bv[0][0]; w.x = pk4_fp8(v[0], v[1], v[2], v[3]); }
                { const f32x4 v = acc[ai][0][m][1] * os + bv[0][1]; w.y = pk4_fp8(v[0], v[1], v[2], v[3]); }
                { const f32x4 v = acc[ai][1][m][0] * os + bv[1][0]; w.z = pk4_fp8(v[0], v[1], v[2], v[3]); }
                { const f32x4 v = acc[ai][1][m][1] * os + bv[1][1]; w.w = pk4_fp8(v[0], v[1], v[2], v[3]); }
                *(u32x4*)(Y + (size_t)(u.pm * BM + ai * HALF + wr * 64 + m * 16 + fr) * DM + col0) = w; }
    }
};
}

#define GAS __attribute__((address_space(1)))
typedef GAS unsigned gu32;
#define RLX_AGENT __ATOMIC_RELAXED, __HIP_MEMORY_SCOPE_AGENT
#define XB_TMO      128
#define XB_XCNT(j)  (256  + 64 * (j))
#define XB_XSUB(j)  (1280 + 64 * (j))
#define XB_XGEN(j)  (2304 + 64 * (j))
#define XB_TOP      3328
#define XB_TOPGEN   3392
#define XCD_BAR_WORDS 3456
#define XB_SPIN_CAP (1u << 18)

__device__ __forceinline__ unsigned xb_ld(unsigned* p)              { return __hip_atomic_load(p, __ATOMIC_RELAXED, __HIP_MEMORY_SCOPE_AGENT); }
__device__ __forceinline__ unsigned xb_add(unsigned* p, unsigned v) { return __hip_atomic_fetch_add(p, v, __ATOMIC_RELAXED, __HIP_MEMORY_SCOPE_AGENT); }
__device__ __forceinline__ unsigned xb_xcc_id() { return (unsigned)__builtin_amdgcn_s_getreg((3 << 11) | 20) & 0xFu; }
#define XB_SPIN(cond, bar) do { unsigned _sp = 0; while (cond) { __builtin_amdgcn_s_sleep(1); \
    if ((++_sp & 255u) == 0u) { if (xb_ld(&(bar)[XB_TMO])) break; if (_sp > XB_SPIN_CAP) { atomicAdd(&(bar)[XB_TMO], 1u); break; } } } } while (0)

struct XcdBarrier {
    unsigned* bar; unsigned x;
    volatile LAS unsigned* st;
};

__device__ __forceinline__ XcdBarrier xcd_barrier_post(unsigned* bar, volatile LAS unsigned* st) {
    XcdBarrier b; b.bar = bar; b.x = xb_xcc_id(); b.st = st;
    if (threadIdx.x == 0) (void)xb_add(&bar[XB_XCNT(b.x)], 1u);
    return b;
}
__device__ __forceinline__ void xcd_barrier_complete(unsigned* bar, unsigned x, unsigned& nloc, unsigned& nx) {
    const unsigned G = gridDim.x * gridDim.y * gridDim.z;
    unsigned sum, cnt, mine, sp = 0u;
    for (;;) {
        sum = 0u; cnt = 0u; mine = 0u;
#pragma unroll
        for (unsigned j = 0; j < 16; ++j) { const unsigned c = xb_ld(&bar[XB_XCNT(j)]); sum += c; cnt += (c > 0u) ? 1u : 0u; mine = (j == x) ? c : mine; }
        if (sum == G) break;
        __builtin_amdgcn_s_sleep(1);
        if ((++sp & 255u) == 0u) { if (xb_ld(&bar[XB_TMO])) break; if (sp > XB_SPIN_CAP) { atomicAdd(&bar[XB_TMO], 1u); break; } }
    }
    nloc = mine > 0u ? mine : 1u; nx = cnt > 0u ? cnt : 1u;
}

__device__ __forceinline__ void xcd_barrier(const XcdBarrier& b) {
    asm volatile("s_waitcnt vmcnt(0)" ::: "memory");
    __syncthreads();
    if (threadIdx.x == 0) {
        unsigned* bar = b.bar;
        __builtin_amdgcn_s_waitcnt(0);
        unsigned nloc = b.st[0], nx = b.st[1];
        if (nloc == 0u) { xcd_barrier_complete(bar, b.x, nloc, nx); b.st[0] = nloc; b.st[1] = nx; }
        const unsigned round = b.st[2]; b.st[2] = round + 1u;
        const unsigned old = xb_add(&bar[XB_XSUB(b.x)], 1u);
        const unsigned gen = old / nloc;
        if (old + 1u == (gen + 1u) * nloc) {
            __builtin_amdgcn_fence(__ATOMIC_RELEASE, "agent");
            asm volatile("s_waitcnt vmcnt(0)" ::: "memory");
            (void)xb_add(&bar[XB_TOP], 1u);
        }
        const unsigned target = (round + 1u) * nx;
        XB_SPIN(xb_ld(&bar[XB_TOP]) < target, bar);
        __builtin_amdgcn_fence(__ATOMIC_ACQUIRE, "agent");
        asm volatile("s_waitcnt vmcnt(0)" ::: "memory");
    }
    __syncthreads();
}


__device__ __forceinline__ int expert_table_lds(const unsigned* cnt, LAS int* tab, int lane, int wave) {
    int mycnt, myts; expert_tiles(cnt, lane, mycnt, myts);
    if (wave == 0 && lane < 32) { tab[lane] = myts; tab[32 + lane] = mycnt; }
    __syncthreads();
    return __builtin_amdgcn_readfirstlane(__shfl(myts, 31) + ((__shfl(mycnt, 31) + 255) >> 8));
}

constexpr int NWAVES = 8;
constexpr int LDS_BYTES = 147456;
constexpr int MISC_OFF = 131072 + 320;
constexpr int TAB_OFF = 131072 + 10240;
constexpr int CW_BAR = 4096;
#ifndef MK_N_LAUNCHES
#define MK_N_LAUNCHES 1
#endif
constexpr int N_PHASES = 9;
struct Args { Params P; int ph_lo, ph_hi; };

__global__ void __launch_bounds__(NWAVES * 64, 2) mk_fwd(Args args) {
    extern __shared__ __attribute__((aligned(16))) unsigned char lds[];
    const Params& P = args.P;
    const int tid = threadIdx.x, lane = tid & 63, wave = __builtin_amdgcn_readfirstlane(tid >> 6);
    const int gw = blockIdx.x * NWAVES + wave, ngw = gridDim.x * NWAVES;
    volatile LAS unsigned* MISC = (volatile LAS unsigned*)((LAS unsigned char*)lds + MISC_OFF);
    for (int u = tid; u < 64; u += NWAVES * 64) MISC[u] = 0u;
    __syncthreads();
    XcdBarrier bar; bar.bar = (unsigned*)(P.ws + WS_CTL) + CW_BAR; bar.x = 0; bar.st = nullptr;
    const int lo = args.ph_lo, hi = args.ph_hi;
    if (hi - lo > 1) bar = xcd_barrier_post((unsigned*)(P.ws + WS_CTL) + CW_BAR, MISC + 8);
#define IN(k) (lo <= (k) && (k) < hi)
#define SEAM(k) do { if (IN(k) && IN((k) + 1)) xcd_barrier(bar); } while (0)
#define RUN(k, ...) do { if (IN(k)) { __VA_ARGS__; } } while (0)
    const bool split_p1 = (gridDim.x == 256) && IN(0) && IN(1);
    constexpr int CONV_Y0 = 24, TI_P0X = 13500, TI_P0 = TI_IN + TI_OUT + TI_P0X;
    RUN(0, p0_prologue(P, gw, ngw, lane, (LAS float*)lds + wave * (64 * 36), split_p1 ? TI_P0 : TI_ALL));
    SEAM(0);
    RUN(1, {
        const int xl = (int)blockIdx.x & 7, yl = (int)blockIdx.x >> 3;
        if (split_p1 && yl >= CONV_Y0) weight_items(P, TI_P0, TI_ALL, ((yl - CONV_Y0) * 8 + xl) * NWAVES + wave, (32 - CONV_Y0) * 8 * NWAVES, lane, (LAS float*)lds + wave * (64 * 36));
        else {
            pg8::DenseOrder S; S.init(P.ws + WS_H1, P.ws + WS_WIN, NTOK, D_IN, DM * 2, split_p1 ? CONV_Y0 * 8 : (int)gridDim.x, split_p1 ? yl * 8 + xl : (int)blockIdx.x);
            const float* RC = (const float*)(P.ws + WS_ROPE);
            pg8::EpiQKV E{(bf16_t*)(P.ws + WS_QKV), P.b_in, RC, RC + (size_t)NTOK * 32};
            pg8::gemm_phase<false, false, pg8::EpiQKV, pg8::DenseOrder, true>((LAS unsigned char*)lds, DM * 2, S, E);
        }
    });
    SEAM(1);
    RUN(2, att::attn_phase(P, (LAS unsigned char*)lds, tid, lane, wave));
    SEAM(2);
    RUN(3, p2b_merge(P, gw, ngw, lane));
    SEAM(3);
    RUN(4, {
        pg8::DenseOrder S; S.init(P.ws + WS_MIXED, P.ws + WS_WOUT, NTOK, DM, DM, (int)gridDim.x, (int)blockIdx.x);
        pg8::EpiOut E{(const bf16_t*)(P.ws + WS_H1), (const float*)(P.ws + WS_SR1), P.g1, (bf16_t*)(P.ws + WS_X1B), P.b_out, 1.0f / (W_FP8_SCALE * MIX_FP8_SCALE)};
        pg8::gemm_phase<false, true, pg8::EpiOut, pg8::DenseOrder, true>((LAS unsigned char*)lds, DM, S, E);
    });
    SEAM(4);
    RUN(5, route::route_phase(P, (LAS unsigned char*)lds, tid, lane, wave));
    SEAM(5);
    RUN(6, {
        LAS int* tab = (LAS int*)((LAS unsigned char*)lds + TAB_OFF);
        const int NT = expert_table_lds((const unsigned*)(P.ws + WS_CTL) + CW_CNT, tab, lane, wave);
        pg8::GroupedOrder S{(const char*)(P.ws + WS_H2), (const char*)(P.ws + WS_W1), (const int*)(P.ws + WS_TOKL), tab, NT, DU / 256, (int)gridDim.x, (int)blockIdx.x, DM, DM, (size_t)DU * DM};
        pg8::EpiSwiglu E{(unsigned char*)(P.ws + WS_HID), P.b1, (const float*)(P.ws + WS_RSL), 1.0f / (W_FP8_SCALE * H2_FP8_SCALE)};
        pg8::gemm_phase<true, true, pg8::EpiSwiglu, pg8::GroupedOrder, true>((LAS unsigned char*)lds, DM, S, E);
    });
    SEAM(6);
    RUN(7, {
        LAS int* tab = (LAS int*)((LAS unsigned char*)lds + TAB_OFF);
        const int NT = expert_table_lds((const unsigned*)(P.ws + WS_CTL) + CW_CNT, tab, lane, wave);
        pg8::GroupedOrder S{(const char*)(P.ws + WS_HID), (const char*)(P.ws + WS_W2), nullptr, tab, NT, DM / 256, (int)gridDim.x, (int)blockIdx.x, DFF, DFF, (size_t)DM * DFF};
        pg8::EpiY E{(unsigned char*)(P.ws + WS_Y), P.b2, 1.0f / (W_FP8_SCALE * HID_FP8_SCALE)};
        pg8::gemm_phase<false, true, pg8::EpiY, pg8::GroupedOrder, true>((LAS unsigned char*)lds, DFF, S, E);
    });
    SEAM(7);
    RUN(8, p7_combine(P, gw, ngw, lane, P.out));
#undef IN
#undef SEAM
#undef RUN
}

extern "C" void kernel_launch(void* const* d_in, const int* in_sizes, int n_in, void* d_out, int out_size, void* d_ws, size_t ws_size, hipStream_t stream) {
    static int grid = 0;
    if (grid == 0) {
        if (n_in != 18 || out_size != NTOK * DM || ws_size < WS_END) { fprintf(stderr, "kernel_launch: unexpected shapes (n_in %d out %d ws %zu)\n", n_in, out_size, ws_size); grid = -1; return; }
        int dev = 0, cus = 0, per_cu = 0;
        if (hipGetDevice(&dev) != hipSuccess || hipDeviceGetAttribute(&cus, hipDeviceAttributeMultiprocessorCount, dev) != hipSuccess) { fprintf(stderr, "kernel_launch: device query failed\n"); grid = -1; return; }
        if (hipFuncSetAttribute((const void*)mk_fwd, hipFuncAttributeMaxDynamicSharedMemorySize, LDS_BYTES) != hipSuccess) { fprintf(stderr, "kernel_launch: hipFuncSetAttribute failed\n"); grid = -1; return; }
        if (hipOccupancyMaxActiveBlocksPerMultiprocessor(&per_cu, (const void*)mk_fwd, NWAVES * 64, LDS_BYTES) != hipSuccess || per_cu < 1) { fprintf(stderr, "kernel_launch: occupancy query says %d blocks/CU; nothing launched\n", per_cu); (void)hipGetLastError(); grid = -1; return; }
        grid = cus;
    }
    if (grid < 0) return;
    Args a{};
    Params& P = a.P;
    P.x = (const float*)d_in[0]; P.pos = (const int*)d_in[1]; P.g1 = (const float*)d_in[2]; P.w_in = (const float*)d_in[3]; P.b_in = (const float*)d_in[4];
    P.sinks = (const float*)d_in[5]; P.gn_dil = (const float*)d_in[6]; P.gn_swa = (const float*)d_in[7]; P.w_out = (const float*)d_in[8]; P.b_out = (const float*)d_in[9];
    P.g2 = (const float*)d_in[10]; P.w_router = (const float*)d_in[11]; P.b_router = (const float*)d_in[12]; P.w1 = (const float*)d_in[13]; P.b1 = (const float*)d_in[14];
    P.w2 = (const float*)d_in[15]; P.b2 = (const float*)d_in[16]; P.gf = (const float*)d_in[17]; P.out = (float*)d_out; P.ws = (unsigned char*)d_ws;
    (void)hipMemsetAsync((char*)d_ws + WS_CTL, 0, CTL_BYTES, stream);
#if MK_N_LAUNCHES == 1
    a.ph_lo = 0; a.ph_hi = N_PHASES;
    hipLaunchKernelGGL(mk_fwd, dim3(grid), dim3(NWAVES * 64), LDS_BYTES, stream, a);
#else
    for (int k = 0; k < N_PHASES; ++k) { a.ph_lo = k; a.ph_hi = k + 1; hipLaunchKernelGGL(mk_fwd, dim3(grid), dim3(NWAVES * 64), LDS_BYTES, stream, a); }
#endif
}
```

```cpp
#include <hip/hip_runtime.h>
#include <cstdio>
#include <cstdint>

#define LAS __attribute__((address_space(3)))
typedef unsigned short bf16_t;
typedef short bf16x8 __attribute__((ext_vector_type(8)));
typedef float f32x4 __attribute__((ext_vector_type(4)));
typedef unsigned u32x4 __attribute__((ext_vector_type(4)));
typedef unsigned u32x2 __attribute__((ext_vector_type(2)));

constexpr int BATCH = 8, SEQ = 4096, DM = 1024, NTOK = BATCH * SEQ;
constexpr int HD = 64, D_IN = 2304;
constexpr int NEXP = 32, DFF = 1024, DU = 2048;
constexpr float EPS = 1e-5f;
constexpr float LOG2E = 1.4426950408889634f;
constexpr float QSCALE = 0.125f * LOG2E;

constexpr size_t MiB = 1u << 20;
constexpr size_t WS_CTL = 0, CTL_BYTES = 1 * MiB;
constexpr size_t WS_WIN = 2 * MiB;
constexpr size_t WS_WRH = 7 * MiB;
constexpr size_t WS_WRL = 7 * MiB + 65536;
constexpr size_t WS_WOUT = 8 * MiB;
constexpr size_t WS_W1 = 16 * MiB;
constexpr size_t WS_W2 = 144 * MiB;
constexpr size_t WS_H1 = 208 * MiB;
constexpr size_t WS_QKV = 272 * MiB;
constexpr size_t WS_PART = 416 * MiB;
constexpr size_t WS_OSWA = 512 * MiB;
constexpr size_t WS_LSE = 544 * MiB;
constexpr size_t WS_MIXED = 548 * MiB;
constexpr size_t WS_H2 = 612 * MiB;
constexpr size_t WS_TOKL = 676 * MiB;
constexpr size_t WS_ASSIGN = 680 * MiB;
constexpr size_t WS_GATE = 680 * MiB + 512 * 1024;
constexpr size_t WS_HID = 682 * MiB;
constexpr size_t WS_ROPE = 954 * MiB;
constexpr size_t WS_RSL = 962 * MiB;
constexpr size_t WS_SR1 = 966 * MiB;
constexpr size_t WS_END = 967 * MiB;
constexpr size_t WS_X1B = 416 * MiB;
constexpr size_t WS_Y = 208 * MiB;
constexpr int CW_CNT = 1024;

struct Params {
    const float* x; const int* pos; const float* g1; const float* w_in; const float* b_in; const float* sinks;
    const float* gn_dil; const float* gn_swa; const float* w_out; const float* b_out; const float* g2;
    const float* w_router; const float* b_router; const float* w1; const float* b1; const float* w2; const float* b2; const float* gf;
    float* out; unsigned char* ws;
};

__device__ __forceinline__ unsigned f2bf(float f) { unsigned u = __builtin_bit_cast(unsigned, f); return (u + 0x7fffu + ((u >> 16) & 1u)) >> 16; }
__device__ __forceinline__ unsigned pk2(float lo, float hi) { return f2bf(lo) | (f2bf(hi) << 16); }
__device__ __forceinline__ float bf2f(unsigned h) { return __builtin_bit_cast(float, h << 16); }
__device__ __forceinline__ float bflo(unsigned w) { return __builtin_bit_cast(float, w << 16); }
__device__ __forceinline__ float bfhi(unsigned w) { return __builtin_bit_cast(float, w & 0xffff0000u); }
__device__ __forceinline__ unsigned pk4_fp8(float a, float b, float c, float d) { int w = 0; w = __builtin_amdgcn_cvt_pk_fp8_f32(a, b, w, false); w = __builtin_amdgcn_cvt_pk_fp8_f32(c, d, w, true); return (unsigned)w; }
constexpr float W_FP8_SCALE = 64.0f;
constexpr float HID_FP8_SCALE = 4.0f;
constexpr float H2_FP8_SCALE = 16.0f;
constexpr float MIX_FP8_SCALE = 16.0f;
constexpr float Y_FP8_SCALE = 16.0f;
__device__ __forceinline__ float wave_sum(float v) {
#pragma unroll
    for (int o = 1; o < 64; o <<= 1) v += __shfl_xor(v, o);
    return v;
}
__host__ __device__ __forceinline__ int qkv_phys32(int n0) { const int pn = n0 >> 8, w = n0 & 255, hh = w >> 6, bj = (w >> 5) & 1; return (pn << 8) + (bj << 7) + (hh << 5); }

template <bool FP8>
__device__ __forceinline__ void transpose_item(const float* W, int K, int N, void* WTv, bool perm, LAS float* scr, int item, int lane) {
    const int nblk = N / 32, kb = item / nblk, nb = item % nblk, k0 = 64 * kb, n0 = 32 * nb;
    const int lr = lane >> 3, lc = (lane & 7) * 4;
    f32x4 v[8];
#pragma unroll
    for (int i = 0; i < 8; ++i) v[i] = __builtin_nontemporal_load((const f32x4*)(W + (size_t)(k0 + 8 * i + lr) * N + n0 + lc));
#pragma unroll
    for (int i = 0; i < 8; ++i) *(LAS f32x4*)(scr + (8 * i + lr) * 36 + (lc ^ (i << 2))) = v[i];
    asm volatile("s_waitcnt lgkmcnt(0)" ::: "memory");
    const int c = lane & 7;
    const int ob = perm ? qkv_phys32(n0) : n0;
#pragma unroll
    for (int j = 0; j < 4; ++j) { const int n = (lane >> 3) + 8 * j; const LAS float* s = scr + (8 * c) * 36 + (n ^ (c << 2));
        if constexpr (FP8) { u32x2 o; o.x = pk4_fp8(s[0 * 36] * W_FP8_SCALE, s[1 * 36] * W_FP8_SCALE, s[2 * 36] * W_FP8_SCALE, s[3 * 36] * W_FP8_SCALE);
            o.y = pk4_fp8(s[4 * 36] * W_FP8_SCALE, s[5 * 36] * W_FP8_SCALE, s[6 * 36] * W_FP8_SCALE, s[7 * 36] * W_FP8_SCALE);
            __builtin_nontemporal_store(o, (u32x2*)((unsigned char*)WTv + (size_t)(ob + n) * K + k0 + 8 * c)); }
        else { u32x4 o; o.x = pk2(s[0 * 36], s[1 * 36]); o.y = pk2(s[2 * 36], s[3 * 36]); o.z = pk2(s[4 * 36], s[5 * 36]); o.w = pk2(s[6 * 36], s[7 * 36]);
            *(u32x4*)((bf16_t*)WTv + (size_t)(ob + n) * K + k0 + 8 * c) = o; } }
    asm volatile("s_waitcnt lgkmcnt(0)" ::: "memory");
}

constexpr int TI_IN = (DM / 64) * (D_IN / 32), TI_OUT = (DM / 64) * (DM / 32), TI_1 = (DM / 64) * (DU / 32), TI_2 = (DFF / 64) * (DM / 32);
constexpr int TI_ALL = TI_IN + TI_OUT + NEXP * (TI_1 + TI_2);
__device__ __forceinline__ void weight_items(const Params& P, int first, int last, int w, int nw, int lane, LAS float* scr) {
    unsigned char* ws = P.ws;
    bf16_t* WIN = (bf16_t*)(ws + WS_WIN); bf16_t* WOUT = (bf16_t*)(ws + WS_WOUT); bf16_t* W1T = (bf16_t*)(ws + WS_W1); bf16_t* W2T = (bf16_t*)(ws + WS_W2);
    for (int it = first + w; it < last; it += nw) {
        int r = it;
        if (r < TI_IN) { transpose_item<false>(P.w_in, DM, D_IN, WIN, true, scr, r, lane); continue; } r -= TI_IN;
        if (r < TI_OUT) { transpose_item<true>(P.w_out, DM, DM, WOUT, false, scr, r, lane); continue; } r -= TI_OUT;
        if (r < NEXP * TI_1) { const int e = r / TI_1; transpose_item<true>(P.w1 + (size_t)e * DM * DU, DM, DU, (unsigned char*)W1T + (size_t)e * DU * DM, false, scr, r % TI_1, lane); continue; } r -= NEXP * TI_1;
        { const int e = r / TI_2; transpose_item<true>(P.w2 + (size_t)e * DFF * DM, DFF, DM, (unsigned char*)W2T + (size_t)e * DM * DFF, false, scr, r % TI_2, lane); }
    }
}
__device__ __forceinline__ void p0_prologue(const Params& P, int gw, int ngw, int lane, LAS float* scr, int n_items) {
    unsigned char* ws = P.ws;
    weight_items(P, 0, n_items, gw, ngw, lane, scr);
    bf16_t* H1 = (bf16_t*)(ws + WS_H1); float* SR1 = (float*)(ws + WS_SR1);
    { f32x4 g[4];
#pragma unroll
      for (int j = 0; j < 4; ++j) g[j] = ((const f32x4*)P.g1 + lane)[64 * j];
      for (int t0 = 4 * gw; t0 < NTOK; t0 += 4 * ngw) {
        f32x4 v[4][4];
#pragma unroll
        for (int q = 0; q < 4; ++q) { const f32x4* xr = (const f32x4*)(P.x + (size_t)(t0 + q) * DM) + lane;
#pragma unroll
            for (int j = 0; j < 4; ++j) v[q][j] = __builtin_nontemporal_load(xr + 64 * j); }
#pragma unroll
        for (int q = 0; q < 4; ++q) { float ss = 0.f;
#pragma unroll
            for (int j = 0; j < 4; ++j) ss += (v[q][j].x * v[q][j].x + v[q][j].y * v[q][j].y) + (v[q][j].z * v[q][j].z + v[q][j].w * v[q][j].w);
            const float sd = sqrtf(wave_sum(ss) * (1.0f / DM) + EPS), rstd = 1.0f / sd;
            if (lane == 0) SR1[t0 + q] = sd;
            u32x2* o = (u32x2*)(H1 + (size_t)(t0 + q) * DM) + lane;
#pragma unroll
            for (int j = 0; j < 4; ++j) { u32x2 w; w.x = pk2(v[q][j].x * rstd * g[j].x, v[q][j].y * rstd * g[j].y); w.y = pk2(v[q][j].z * rstd * g[j].z, v[q][j].w * rstd * g[j].w); o[64 * j] = w; } }
      } }
    { bf16_t* WRH = (bf16_t*)(ws + WS_WRH); bf16_t* WRL = (bf16_t*)(ws + WS_WRL);
      for (int idx = gw * 64 + lane; idx < NEXP * DM; idx += ngw * 64) { const int e = idx >> 10, k = idx & 1023;
          const float w = P.w_router[k * NEXP + e]; const unsigned h = f2bf(w); WRH[idx] = (bf16_t)h; WRL[idx] = (bf16_t)f2bf(w - bf2f(h)); } }
    _Float16* RC = (_Float16*)(ws + WS_ROPE); _Float16* RS = RC + (size_t)NTOK * 32;
    for (int idx = gw * 64 + lane; idx < NTOK * 32; idx += ngw * 64) {
        const int t = idx >> 5, i = idx & 31;
        const float inv = (float)exp2(-(double)i * (13.287712379549449 / 32.0));
        const float ang = (float)P.pos[t] * inv;
        const double a = (double)ang * 0.15915494309189535;
        const float fr = (float)(a - rint(a));
        RC[idx] = (_Float16)__builtin_amdgcn_cosf(fr); RS[idx] = (_Float16)__builtin_amdgcn_sinf(fr);
    }
}

namespace att {
typedef float f32x16 __attribute__((ext_vector_type(16)));
typedef short s16x4 __attribute__((ext_vector_type(4)));
constexpr int OOFF = 98304;
constexpr int KOFF = 0, VOFF = 49152;
constexpr float THR = 8.0f;
__device__ __forceinline__ int crow(int r, int hi) { return (r & 3) + 8 * (r >> 2) + 4 * hi; }
__device__ __forceinline__ s16x4 vtr(const LAS unsigned char* p) { return __builtin_bit_cast(s16x4, __builtin_amdgcn_ds_read_tr16_b64_v4i16((LAS s16x4*)p)); }
__device__ __forceinline__ void xswap(float v, float& a, float& b) { const unsigned u = __builtin_bit_cast(unsigned, v); auto rr = __builtin_amdgcn_permlane32_swap(u, u, false, false); const unsigned r0 = rr[0], r1 = rr[1]; a = __builtin_bit_cast(float, r0); b = __builtin_bit_cast(float, r1); }
__device__ __forceinline__ float xmax(float v) { float a, b; xswap(v, a, b); return fmaxf(a, b); }
__device__ __forceinline__ float xsum(float v) { float a, b; xswap(v, a, b); return a + b; }
__device__ __forceinline__ unsigned cvtpk(float lo, float hi) { unsigned r; asm("v_cvt_pk_bf16_f32 %0, %1, %2" : "=v"(r) : "v"(lo), "v"(hi)); return r; }

struct UnitInfo { int kind, h, r, nb, dm; size_t tok0; const bf16_t* qb; const bf16_t* kb; const bf16_t* vb; };
__device__ __forceinline__ UnitInfo decode(const Params& P, int unit) {
    UnitInfo u; const bf16_t* QKV = (const bf16_t*)(P.ws + WS_QKV);
    const int kind = unit >> 10, within = unit & 1023, b = within >> 7, h = (within >> 4) & 7, sub = within & 15;
    int r, c, nb, hq, hk, hv;
    if (kind == 0) { r = 1; c = 0; nb = sub; } else if (kind == 1) { r = 4; c = sub >> 2; nb = sub & 3; } else if (kind == 2) { r = 16; c = sub; nb = 0; } else { r = 1; c = 0; nb = sub; }
    if (kind < 3) { hq = h; hk = 8 + h; hv = 16 + h; u.dm = 0; } else { hq = 24 + h; hk = 32 + (h >> 2); hv = 34 + (h >> 2); u.dm = 1; }
    u.kind = kind; u.h = h; u.r = r; u.nb = nb; u.tok0 = (size_t)b * SEQ + c;
    u.qb = QKV + ((size_t)hq * NTOK + u.tok0) * 64; u.kb = QKV + ((size_t)hk * NTOK + u.tok0) * 64; u.vb = QKV + ((size_t)hv * NTOK + u.tok0) * 64;
    return u;
}
__device__ __forceinline__ void unit_loads(const UnitInfo& u, int tid, int lane, int wave, u32x4 (&kv)[6], u32x4 (&vv)[6], bf16x8 (&q)[4]) {
    const int c8 = tid & 7, j0 = tid >> 3, kbase = 256 * u.nb - 128;
#pragma unroll
    for (int i = 0; i < 6; ++i) { if (u.nb > 0 || i >= 2) { const long l = kbase + j0 + 64 * i; kv[i] = *(const u32x4*)(u.kb + l * u.r * 64 + c8 * 8); vv[i] = *(const u32x4*)(u.vb + l * u.r * 64 + c8 * 8); } }
    const bf16_t* qp = u.qb + (size_t)(256 * u.nb + 32 * wave + (lane & 31)) * u.r * 64 + 8 * (lane >> 5);
#pragma unroll
    for (int d0 = 0; d0 < 4; ++d0) q[d0] = *(const bf16x8*)(qp + 16 * d0);
}
__device__ __forceinline__ void unit_fill(LAS unsigned char* lds, int nb, int tid, const u32x4 (&kv)[6], const u32x4 (&vv)[6]) {
    const int c8 = tid & 7, j0 = tid >> 3, key = j0 & 31;
    LAS unsigned char* kd = lds + KOFF + (j0 >> 5) * 4096 + key * 128 + ((c8 ^ ((key >> 1) & 7)) << 4);
    LAS unsigned char* vd = lds + VOFF + (c8 >> 2) * 4096 + j0 * 64 + (c8 & 3) * 16;
#pragma unroll
    for (int i = 0; i < 6; ++i) { if (nb > 0 || i >= 2) { *(LAS u32x4*)(kd + i * 8192) = kv[i]; *(LAS u32x4*)(vd + i * 8192) = vv[i]; } }
}
__device__ __forceinline__ void unit_compute(const Params& P, LAS unsigned char* lds, const UnitInfo& u, const bf16x8 (&qr)[4], int lane, int wave) {
    const int r32 = lane & 31, hi = lane >> 5, nb = u.nb;
    float mref = -INFINITY, l = 0.f; f32x16 o[2];
#pragma unroll
    for (int x = 0; x < 16; ++x) { o[0][x] = 0.f; o[1][x] = 0.f; }
    const int vlane = ((lane >> 4) & 1) * 32 + (lane & 3) * 8 + (4 * hi + ((lane & 15) >> 2)) * 64;
#pragma unroll
    for (int jt = 4; jt >= 0; --jt) {
        const int kt = wave + jt;
        if (nb == 0 && kt < 4) break;
        const LAS unsigned char* kb = lds + KOFF + kt * 4096 + r32 * 128;
        f32x16 p;
#pragma unroll
        for (int x = 0; x < 16; ++x) p[x] = 0.f;
#pragma unroll
        for (int d0 = 0; d0 < 4; ++d0) { const bf16x8 kf = *(const LAS bf16x8*)(kb + (((2 * d0 + hi) ^ ((r32 >> 1) & 7)) << 4)); p = __builtin_amdgcn_mfma_f32_32x32x16_bf16(kf, qr[d0], p, 0, 0, 0); }
        if (jt == 4) {
#pragma unroll
            for (int x = 0; x < 16; ++x) if (crow(x, hi) > r32) p[x] = -INFINITY;
        }
        if (jt == 0) {
#pragma unroll
            for (int x = 0; x < 16; ++x) if (crow(x, hi) < r32 + u.dm) p[x] = -INFINITY;
        }
        float tm = fmaxf(fmaxf(p[0], p[1]), p[2]);
#pragma unroll
        for (int x = 3; x < 15; x += 2) tm = fmaxf(fmaxf(tm, p[x]), p[x + 1]);
        tm = xmax(fmaxf(tm, p[15]));
        const float mn = fmaxf(mref, tm), al = __builtin_amdgcn_exp2f(mref - mn);
        mref = mn;
        float ls = 0.f;
#pragma unroll
        for (int x = 0; x < 16; ++x) { p[x] = __builtin_amdgcn_exp2f(p[x] - mn); ls += p[x]; }
        l = l * al + ls;
#pragma unroll
        for (int x = 0; x < 16; ++x) { o[0][x] *= al; o[1][x] *= al; }
        u32x4 pw[2];
#pragma unroll
        for (int s2 = 0; s2 < 2; ++s2) { pw[s2].x = cvtpk(p[8 * s2 + 0], p[8 * s2 + 1]); pw[s2].y = cvtpk(p[8 * s2 + 2], p[8 * s2 + 3]); pw[s2].z = cvtpk(p[8 * s2 + 4], p[8 * s2 + 5]); pw[s2].w = cvtpk(p[8 * s2 + 6], p[8 * s2 + 7]); }
        const LAS unsigned char* vb = lds + VOFF + (kt >> 1) * 8192 + (kt & 1) * 2048 + vlane;
#pragma unroll
        for (int d0 = 0; d0 < 2; ++d0)
#pragma unroll
            for (int s2 = 0; s2 < 2; ++s2) { const s16x4 lo = vtr(vb + d0 * 4096 + s2 * 1024), hh = vtr(vb + d0 * 4096 + s2 * 1024 + 512);
                const bf16x8 vf = (bf16x8){lo[0], lo[1], lo[2], lo[3], hh[0], hh[1], hh[2], hh[3]};
                o[d0] = __builtin_amdgcn_mfma_f32_32x32x16_bf16(vf, __builtin_bit_cast(bf16x8, pw[s2]), o[d0], 0, 0, 0); }
    }
    l = xsum(l);
    const size_t t = u.tok0 + (size_t)(256 * nb + 32 * wave + r32) * u.r;
    float inv; bf16_t* dst; size_t pitch;
    if (u.kind < 3) { inv = 1.0f / l; dst = (bf16_t*)(P.ws + WS_PART) + ((size_t)u.kind * NTOK + u.tok0 + (size_t)(256 * nb + 32 * wave) * u.r) * 512 + u.h * 64;
        if (hi == 0) ((float*)(P.ws + WS_LSE))[((size_t)u.kind * NTOK + t) * 8 + u.h] = mref + __builtin_amdgcn_logf(l); }
    else { inv = 1.0f / (l + __builtin_amdgcn_exp2f(P.sinks[u.h] * LOG2E - mref)); dst = (bf16_t*)(P.ws + WS_OSWA) + (u.tok0 + (size_t)(256 * nb + 32 * wave) * u.r) * 512 + u.h * 64; }
    pitch = (size_t)u.r * 512;
    LAS unsigned char* stg = lds + OOFF + wave * 4096;
#pragma unroll
    for (int d0 = 0; d0 < 2; ++d0)
#pragma unroll
        for (int g = 0; g < 4; ++g) { u32x2 w; w.x = cvtpk(o[d0][4 * g] * inv, o[d0][4 * g + 1] * inv); w.y = cvtpk(o[d0][4 * g + 2] * inv, o[d0][4 * g + 3] * inv);
            *(LAS u32x2*)(stg + r32 * 128 + (((4 * d0 + g) ^ (r32 & 7)) << 4) + 8 * hi) = w; }
#pragma unroll
    for (int i = 0; i < 4; ++i) { const int row = 8 * i + (lane >> 3), ch = lane & 7;
        const u32x4 v = *(const LAS u32x4*)(stg + row * 128 + ((ch ^ (row & 7)) << 4));
        *(u32x4*)(dst + (size_t)row * pitch + 8 * ch) = v; }
}
__device__ __forceinline__ int unit_of(int it, int wg, int G) {
    if (G != 256) return it * G + wg;
    const int x = wg & 7, y = wg >> 3;
    const int gl = 2 * it + (y >> 4), sub = y & 15;
    int kind, b, h;
    if (gl < 24) { kind = gl >> 3; b = gl & 7; h = x; } else { const int q = gl - 24; kind = 3; b = 4 * (q >> 2 & 1) + (x >> 1); h = 4 * (x & 1) + (q & 3); }
    return (kind << 10) | (b << 7) | (h << 4) | sub;
}
__device__ __forceinline__ void attn_phase(const Params& P, LAS unsigned char* lds, int tid, int lane, int wave) {
    const int G = gridDim.x, nit = (4096 + G - 1) / G; int it = 0;
    int unit = unit_of(0, blockIdx.x, G); if (unit >= 4096) return;
    UnitInfo cur = decode(P, unit);
    u32x4 kv[6], vv[6]; bf16x8 qn[4];
    unit_loads(cur, tid, lane, wave, kv, vv, qn);
    for (;;) {
        unit_fill(lds, cur.nb, tid, kv, vv);
        bf16x8 qr[4];
#pragma unroll
        for (int d0 = 0; d0 < 4; ++d0) qr[d0] = qn[d0];
        __syncthreads();
        const int nunit = (it + 1 < nit) ? unit_of(it + 1, blockIdx.x, G) : 4096; const bool has_next = nunit < 4096;
        UnitInfo nxt = cur;
        if (has_next) { nxt = decode(P, nunit); unit_loads(nxt, tid, lane, wave, kv, vv, qn); }
        unit_compute(P, lds, cur, qr, lane, wave);
        __syncthreads();
        if (!has_next) break;
        cur = nxt; unit = nunit; ++it;
    }
}
}

__device__ __forceinline__ void p2b_merge(const Params& P, int gw, int ngw, int lane) {
    unsigned char* ws = P.ws;
    const bf16_t* PART = (const bf16_t*)(ws + WS_PART); const bf16_t* OSWA = (const bf16_t*)(ws + WS_OSWA); const float* LSE = (const float*)(ws + WS_LSE);
    unsigned char* MIXED = ws + WS_MIXED;
    const f32x4 gda = *(const f32x4*)(P.gn_dil + lane * 8), gdb = *(const f32x4*)(P.gn_dil + lane * 8 + 4), gsa = *(const f32x4*)(P.gn_swa + lane * 8), gsb = *(const f32x4*)(P.gn_swa + lane * 8 + 4);
    const int h = lane >> 3;
    for (int t0 = 4 * gw; t0 < NTOK; t0 += 4 * ngw) {
        float ls[4][3]; u32x4 pv[4][3], sv[4];
#pragma unroll
        for (int q = 0; q < 4; ++q) { const int t = t0 + q;
#pragma unroll
            for (int c = 0; c < 3; ++c) { ls[q][c] = LSE[((size_t)c * NTOK + t) * 8 + h]; pv[q][c] = *(const u32x4*)(PART + ((size_t)c * NTOK + t) * 512 + lane * 8); }
            sv[q] = *(const u32x4*)(OSWA + (size_t)t * 512 + lane * 8); }
#pragma unroll
        for (int q = 0; q < 4; ++q) { const int t = t0 + q;
            const float mx = fmaxf(fmaxf(ls[q][0], ls[q][1]), ls[q][2]);
            float wsum = 0.f, w[3];
#pragma unroll
            for (int c = 0; c < 3; ++c) { w[c] = exp2f(ls[q][c] - mx); wsum += w[c]; }
            const float winv = 1.0f / wsum;
            float o[8];
#pragma unroll
            for (int i = 0; i < 8; ++i) o[i] = 0.f;
#pragma unroll
            for (int c = 0; c < 3; ++c) { const u32x4 v = pv[q][c]; const float wc = w[c] * winv;
                o[0] += wc * bflo(v.x); o[1] += wc * bfhi(v.x); o[2] += wc * bflo(v.y); o[3] += wc * bfhi(v.y);
                o[4] += wc * bflo(v.z); o[5] += wc * bfhi(v.z); o[6] += wc * bflo(v.w); o[7] += wc * bfhi(v.w); }
            float ss = 0.f;
#pragma unroll
            for (int i = 0; i < 8; ++i) ss += o[i] * o[i];
            float rstd = MIX_FP8_SCALE / sqrtf(wave_sum(ss) * (1.0f / 512.0f) + EPS);
            { u32x2 w2; w2.x = pk4_fp8(o[0] * rstd * gda.x, o[1] * rstd * gda.y, o[2] * rstd * gda.z, o[3] * rstd * gda.w);
              w2.y = pk4_fp8(o[4] * rstd * gdb.x, o[5] * rstd * gdb.y, o[6] * rstd * gdb.z, o[7] * rstd * gdb.w);
              *(u32x2*)(MIXED + (size_t)t * DM + lane * 8) = w2; }
            { const u32x4 v = sv[q];
              o[0] = bflo(v.x); o[1] = bfhi(v.x); o[2] = bflo(v.y); o[3] = bfhi(v.y); o[4] = bflo(v.z); o[5] = bfhi(v.z); o[6] = bflo(v.w); o[7] = bfhi(v.w); }
            ss = 0.f;
#pragma unroll
            for (int i = 0; i < 8; ++i) ss += o[i] * o[i];
            rstd = MIX_FP8_SCALE / sqrtf(wave_sum(ss) * (1.0f / 512.0f) + EPS);
            { u32x2 w2; w2.x = pk4_fp8(o[0] * rstd * gsa.x, o[1] * rstd * gsa.y, o[2] * rstd * gsa.z, o[3] * rstd * gsa.w);
              w2.y = pk4_fp8(o[4] * rstd * gsb.x, o[5] * rstd * gsb.y, o[6] * rstd * gsb.z, o[7] * rstd * gsb.w);
              *(u32x2*)(MIXED + (size_t)t * DM + 512 + lane * 8) = w2; }
        }
    }
}

namespace route {
constexpr int NWAVES_R = 8;
constexpr int R_W = 0;
constexpr int R_LCNT = 131072 + 1024;
constexpr int R_REC = R_LCNT + 256;
constexpr int R_G2 = 131072 + 10240;
constexpr int XPRE = 24;
__device__ __forceinline__ void merge4(float (&v)[4], int (&e)[4], const float (&pv)[4], const int (&pe)[4]) {
    float cv[8]; int ce[8];
#pragma unroll
    for (int k = 0; k < 4; ++k) { cv[k] = v[k]; ce[k] = e[k]; cv[4 + k] = pv[k]; ce[4 + k] = pe[k]; }
#pragma unroll
    for (int k = 0; k < 4; ++k) { float best = -INFINITY; int bi = 0, be = 0;
#pragma unroll
        for (int x = 0; x < 8; ++x) { const bool better = (cv[x] > best) || (cv[x] == best && ce[x] < be); if (better) { best = cv[x]; bi = x; be = ce[x]; } }
        v[k] = best; e[k] = be;
#pragma unroll
        for (int x = 0; x < 8; ++x) cv[x] = (x == bi) ? -INFINITY : cv[x]; }
}
typedef float rf32x2 __attribute__((ext_vector_type(2)));
typedef __bf16 rbf16x2 __attribute__((ext_vector_type(2)));
__device__ __forceinline__ unsigned cvtpk(float lo, float hi) { const rf32x2 v = {lo, hi}; return __builtin_bit_cast(unsigned, __builtin_convertvector(v, rbf16x2)); }
__device__ __forceinline__ void route_block(const Params& P, LAS unsigned char* lds, int tb, int tid, int lane, int wave, bool stage) {
    unsigned char* ws = P.ws;
    bf16_t* H2 = (bf16_t*)(ws + WS_H2);
    const int tk = lane & 15, fq = lane >> 4;
    const int t = tb * 128 + wave * 16 + tk;
    LAS unsigned* lcnt = (LAS unsigned*)(lds + R_LCNT);
    const bf16_t* xp = (const bf16_t*)(ws + WS_X1B) + (size_t)t * DM + 8 * fq;
    if (stage) {
        const u32x4* src = (const u32x4*)(P.ws + WS_WRH);
#pragma unroll 4
        for (int i = tid; i < 8192; i += NWAVES_R * 64) { const int half = i >> 12, e = (i >> 7) & 31, ch = i & 127;
            *(LAS u32x4*)(lds + R_W + half * 65536 + e * 2048 + ((ch ^ (e & 15)) << 4)) = src[i]; }
        if (tid < 256) *(LAS f32x4*)(lds + R_G2 + tid * 16) = *(const f32x4*)(P.g2 + tid * 4);
    }
    u32x4 xwv[32];
#pragma unroll
    for (int ks = 0; ks < XPRE; ++ks) xwv[ks] = *(const u32x4*)(xp + 32 * ks);
    if (tid < 64) lcnt[tid] = 0u;
    asm volatile("s_waitcnt vmcnt(0) lgkmcnt(0)" ::: "memory");
    __builtin_amdgcn_s_barrier();
    const LAS float* gp = (const LAS float*)(lds + R_G2) + 8 * fq;
    const LAS unsigned char* wrow = lds + R_W + tk * 2048;
    unsigned char* hp = (unsigned char*)H2 + (size_t)t * DM + 8 * fq;
    f32x4 d0 = {0.f, 0.f, 0.f, 0.f}, d1 = {0.f, 0.f, 0.f, 0.f};
    float ss = 0.f;
#pragma unroll
    for (int ks = 0; ks < 32; ++ks) {
        if (ks == 32 - XPRE) {
#pragma unroll
            for (int k2 = XPRE; k2 < 32; ++k2) xwv[k2] = *(const u32x4*)(xp + 32 * k2); }
        const u32x4 xw = xwv[ks]; const f32x4 xa = {bflo(xw.x), bfhi(xw.x), bflo(xw.y), bfhi(xw.y)}, xb = {bflo(xw.z), bfhi(xw.z), bflo(xw.w), bfhi(xw.w)}, ga = *(const LAS f32x4*)(gp + 32 * ks), gb = *(const LAS f32x4*)(gp + 32 * ks + 4);
        const int wo = ((4 * ks + fq) ^ tk) << 4;
        const bf16x8 ah0 = *(const LAS bf16x8*)(wrow + wo), al0 = *(const LAS bf16x8*)(wrow + 65536 + wo), ah1 = *(const LAS bf16x8*)(wrow + 32768 + wo), al1 = *(const LAS bf16x8*)(wrow + 98304 + wo);
        ss += (xa.x * xa.x + xa.y * xa.y) + (xa.z * xa.z + xa.w * xa.w) + (xb.x * xb.x + xb.y * xb.y) + (xb.z * xb.z + xb.w * xb.w);
        const f32x4 ha = xa * ga, hb = xb * gb;
        u32x4 bh, bl;
        bh.x = cvtpk(ha[0], ha[1]); bh.y = cvtpk(ha[2], ha[3]); bh.z = cvtpk(hb[0], hb[1]); bh.w = cvtpk(hb[2], hb[3]);
        bl.x = cvtpk(ha[0] - bflo(bh.x), ha[1] - bfhi(bh.x)); bl.y = cvtpk(ha[2] - bflo(bh.y), ha[3] - bfhi(bh.y)); bl.z = cvtpk(hb[0] - bflo(bh.z), hb[1] - bfhi(bh.z)); bl.w = cvtpk(hb[2] - bflo(bh.w), hb[3] - bfhi(bh.w));
        { u32x2 h8; h8.x = pk4_fp8(ha[0] * H2_FP8_SCALE, ha[1] * H2_FP8_SCALE, ha[2] * H2_FP8_SCALE, ha[3] * H2_FP8_SCALE); h8.y = pk4_fp8(hb[0] * H2_FP8_SCALE, hb[1] * H2_FP8_SCALE, hb[2] * H2_FP8_SCALE, hb[3] * H2_FP8_SCALE); *(u32x2*)(hp + 32 * ks) = h8; }
        const bf16x8 bhv = __builtin_bit_cast(bf16x8, bh), blv = __builtin_bit_cast(bf16x8, bl);
        d0 = __builtin_amdgcn_mfma_f32_16x16x32_bf16(ah0, bhv, d0, 0, 0, 0); d1 = __builtin_amdgcn_mfma_f32_16x16x32_bf16(ah1, bhv, d1, 0, 0, 0);
        d0 = __builtin_amdgcn_mfma_f32_16x16x32_bf16(al0, bhv, d0, 0, 0, 0); d1 = __builtin_amdgcn_mfma_f32_16x16x32_bf16(al1, bhv, d1, 0, 0, 0);
        d0 = __builtin_amdgcn_mfma_f32_16x16x32_bf16(ah0, blv, d0, 0, 0, 0); d1 = __builtin_amdgcn_mfma_f32_16x16x32_bf16(ah1, blv, d1, 0, 0, 0);
    }
    ss += __shfl_xor(ss, 16); ss += __shfl_xor(ss, 32);
    const float rstd = 1.0f / sqrtf(ss * (1.0f / DM) + EPS);
    float v[8]; int ve[8];
#pragma unroll
    for (int i = 0; i < 4; ++i) { ve[i] = 4 * fq + i; ve[4 + i] = 16 + 4 * fq + i; v[i] = d0[i] * rstd + P.b_router[ve[i]]; v[4 + i] = d1[i] * rstd + P.b_router[ve[4 + i]]; }
    float tv[4]; int te[4];
#pragma unroll
    for (int k = 0; k < 4; ++k) { float best = -INFINITY; int bi = 0;
#pragma unroll
        for (int x = 0; x < 8; ++x) if (v[x] > best) { best = v[x]; bi = x; }
        tv[k] = best; te[k] = (bi < 4) ? (4 * fq + bi) : (12 + 4 * fq + bi);
#pragma unroll
        for (int x = 0; x < 8; ++x) v[x] = (x == bi) ? -INFINITY : v[x]; }
#pragma unroll
    for (int rnd = 0; rnd < 2; ++rnd) { float pv[4]; int pe[4];
#pragma unroll
        for (int k = 0; k < 4; ++k) { pv[k] = __shfl_xor(tv[k], 16 << rnd); pe[k] = __shfl_xor(te[k], 16 << rnd); }
        merge4(tv, te, pv, pe); }
    float gate[4], sum = 0.f;
#pragma unroll
    for (int k = 0; k < 4; ++k) { gate[k] = __expf(tv[k] - tv[0]); sum += gate[k]; }
    const float rs = 1.0f / sum;
    if (fq == 0) {
#pragma unroll
        for (int k = 0; k < 4; ++k) { const unsigned rank = __hip_atomic_fetch_add(&lcnt[te[k]], 1u, __ATOMIC_RELAXED, __HIP_MEMORY_SCOPE_WORKGROUP);
            *(LAS u32x4*)(lds + R_REC + ((wave * 16 + tk) * 4 + k) * 16) = (u32x4){(unsigned)te[k], rank, __builtin_bit_cast(unsigned, gate[k] * rs), __builtin_bit_cast(unsigned, rstd)}; } }
    __syncthreads();
    if (tid < 32) { unsigned* cnt = (unsigned*)(ws + WS_CTL) + CW_CNT; const unsigned c = lcnt[tid]; lcnt[32 + tid] = c ? atomicAdd(cnt + tid, c) : 0u; }
    __syncthreads();
    { int* TOKL = (int*)(ws + WS_TOKL); int* ASSIGN = (int*)(ws + WS_ASSIGN); float* GATE = (float*)(ws + WS_GATE); float* RSL = (float*)(ws + WS_RSL);
      const u32x4 rec = *(const LAS u32x4*)(lds + R_REC + tid * 16);
      const int tt = tb * 128 + (tid >> 2); const unsigned e = rec.x, pos = lcnt[32 + e] + rec.y;
      const unsigned gbits = rec.z, rbits = rec.w;
      TOKL[e * NTOK + pos] = tt; RSL[e * NTOK + pos] = __builtin_bit_cast(float, rbits); ASSIGN[tt * 4 + (tid & 3)] = (int)((e << 16) | pos); GATE[tt * 4 + (tid & 3)] = __builtin_bit_cast(float, gbits); }
    __syncthreads();
}
__device__ __forceinline__ void route_phase(const Params& P, LAS unsigned char* lds, int tid, int lane, int wave) {
    if ((int)blockIdx.x >= NTOK / 128) return;
    for (int tb = blockIdx.x; tb < NTOK / 128; tb += gridDim.x) route_block(P, lds, tb, tid, lane, wave, tb == (int)blockIdx.x);
}
}

__device__ __forceinline__ void expert_tiles(const unsigned* cnt, int lane, int& my_cnt, int& my_tstart) {
    const int c = (int)__hip_atomic_load(cnt + (lane & 31), __ATOMIC_RELAXED, __HIP_MEMORY_SCOPE_AGENT);
    const int tl = (c + 255) >> 8; int inc = tl;
#pragma unroll
    for (int o = 1; o < 32; o <<= 1) { const int up = __shfl_up(inc, o, 32); if ((lane & 31) >= o) inc += up; }
    my_cnt = c; my_tstart = inc - tl;
}

__device__ __forceinline__ void p7_combine(const Params& P, int gw, int ngw, int lane, float* dstbase) {
    typedef float f32x2 __attribute__((ext_vector_type(2)));
    unsigned char* ws = P.ws;
    const unsigned char* Y = (const unsigned char*)(ws + WS_Y); const u32x4* ASSIGN = (const u32x4*)(ws + WS_ASSIGN); const f32x4* GATE = (const f32x4*)(ws + WS_GATE);
    const unsigned* cnt = (const unsigned*)(ws + WS_CTL) + CW_CNT;
    int mycnt, myts; expert_tiles(cnt, lane, mycnt, myts);
    f32x4 gf4[4];
#pragma unroll
    for (int j = 0; j < 4; ++j) gf4[j] = *((const f32x4*)P.gf + 4 * lane + j);
    int t0 = 2 * gw; if (t0 >= NTOK) return;
    u32x4 an[2]; f32x4 gn[2];
#pragma unroll
    for (int q = 0; q < 2; ++q) { an[q] = ASSIGN[t0 + q]; gn[q] = GATE[t0 + q]; }
    for (; t0 < NTOK; t0 += 2 * ngw) {
        u32x4 a[2]; f32x4 g[2];
#pragma unroll
        for (int q = 0; q < 2; ++q) { a[q] = an[q]; g[q] = gn[q]; }
        const int tn = (t0 + 2 * ngw < NTOK) ? t0 + 2 * ngw : t0;
#pragma unroll
        for (int q = 0; q < 2; ++q) { an[q] = ASSIGN[tn + q]; gn[q] = GATE[tn + q]; }
        u32x4 yv[2][4], xa[2], xb[2];
#pragma unroll
        for (int q = 0; q < 2; ++q) { const u32x4* xr = (const u32x4*)((const bf16_t*)(ws + WS_X1B) + (size_t)(t0 + q) * DM) + 2 * lane; xa[q] = xr[0]; xb[q] = xr[1];
            const unsigned aw[4] = {a[q].x, a[q].y, a[q].z, a[q].w};
#pragma unroll
            for (int k = 0; k < 4; ++k) { const int e = (int)(aw[k] >> 16), pos = (int)(aw[k] & 0xffffu); const int ts = __shfl(myts, e); yv[q][k] = __builtin_nontemporal_load((const u32x4*)(Y + ((size_t)ts * 256 + pos) * DM) + lane); } }
#pragma unroll
        for (int q = 0; q < 2; ++q) {
            f32x4 v[4];
            v[0] = (f32x4){bflo(xa[q].x), bfhi(xa[q].x), bflo(xa[q].y), bfhi(xa[q].y)}; v[1] = (f32x4){bflo(xa[q].z), bfhi(xa[q].z), bflo(xa[q].w), bfhi(xa[q].w)};
            v[2] = (f32x4){bflo(xb[q].x), bfhi(xb[q].x), bflo(xb[q].y), bfhi(xb[q].y)}; v[3] = (f32x4){bflo(xb[q].z), bfhi(xb[q].z), bflo(xb[q].w), bfhi(xb[q].w)};
            const float gk[4] = {g[q].x * (1.0f / Y_FP8_SCALE), g[q].y * (1.0f / Y_FP8_SCALE), g[q].z * (1.0f / Y_FP8_SCALE), g[q].w * (1.0f / Y_FP8_SCALE)};
#pragma unroll
            for (int k = 0; k < 4; ++k) { const unsigned yw[4] = {yv[q][k].x, yv[q][k].y, yv[q][k].z, yv[q][k].w};
#pragma unroll
                for (int j = 0; j < 4; ++j) { const f32x2 lo = __builtin_amdgcn_cvt_pk_f32_fp8((int)yw[j], false), hi = __builtin_amdgcn_cvt_pk_f32_fp8((int)yw[j], true);
                    v[j].x += gk[k] * lo.x; v[j].y += gk[k] * lo.y; v[j].z += gk[k] * hi.x; v[j].w += gk[k] * hi.y; } }
            float ss = 0.f;
#pragma unroll
            for (int j = 0; j < 4; ++j) ss += (v[j].x * v[j].x + v[j].y * v[j].y) + (v[j].z * v[j].z + v[j].w * v[j].w);
            const float rstd = 1.0f / sqrtf(wave_sum(ss) * (1.0f / DM) + EPS);
            f32x4* dr = (f32x4*)(dstbase + (size_t)(t0 + q) * DM) + 4 * lane;
#pragma unroll
            for (int j = 0; j < 4; ++j) dr[j] = v[j] * rstd * gf4[j];
        }
    }
}

namespace pg8 {
constexpr int BM = 256, BK = 64, HALF = 128, HTB = HALF * BK * 2, STAGE_BYTES = 8 * HTB, NXCD = 8, WGM = 8;
constexpr int EPI_SLOT_OFF = 131072 + 10240 + 512;
__host__ __device__ __forceinline__ int lds_byte(int r, int c) { const int st = (r >> 4) * 2 + (c >> 5), rr = r & 15, cc = c & 31, ob = rr * 64 + cc * 2; return st * 1024 + (ob ^ (((ob >> 9) & 1) << 5)); }
__host__ __device__ __forceinline__ void stage_rc(int b, int& R, int& C) { const int st = b / 1024, sb = b % 1024, swz = sb ^ (((sb >> 9) & 1) << 5); R = (st >> 1) * 16 + swz / 64; C = (st & 1) * 32 + (swz % 64) / 2; }
__host__ __device__ __forceinline__ int perm32(int rho) { const int n = rho >> 4, i = rho & 15; return 8 * (i >> 2) + 4 * n + (i & 3); }
struct Unit { int pm, pn, e, rt; };

__device__ __forceinline__ bool tile_order(int i, int G, int c, int nM, int nN, int& pm, int& pn) {
    const int nwg = nM * nN; const long L = (long)i * G + c; if (L >= nwg) return false;
    int wgid = (int)L; { const int q = nwg / NXCD, r = nwg % NXCD, xcd = wgid % NXCD, off = wgid / NXCD; wgid = (xcd < r ? xcd * (q + 1) : r * (q + 1) + (xcd - r) * q) + off; }
    const int nig = WGM * nN, gid = wgid / nig, fm = gid * WGM, gsz = (nM - fm) < WGM ? (nM - fm) : WGM;
    pm = fm + ((wgid % nig) % gsz); pn = (wgid % nig) / gsz; return true;
}
struct DenseOrder {
    const char* A; const char* Bt; int nM, nN, G, c; size_t tstep;
    __device__ __forceinline__ void init(const void* A_, const void* Bt_, int M, int N, int KB, int G_, int c_) { A = (const char*)A_; Bt = (const char*)Bt_; nM = M / BM; nN = N / BM; G = G_; c = c_; tstep = (size_t)BM * KB; }
    __device__ __forceinline__ bool next(int i, Unit& u) const { u.e = 0; u.rt = 0; return tile_order(i, G, c, nM, nN, u.pm, u.pn); }
    __device__ __forceinline__ const char* a_base(const Unit& u) const { return A + (size_t)u.pm * tstep; }
    __device__ __forceinline__ const char* b_base(const Unit& u) const { return Bt + (size_t)u.pn * tstep; }
    __device__ __forceinline__ void a_rows(const Unit&, unsigned (&)[2][2]) const {}
    __device__ __forceinline__ void a_rows_stage(const Unit&, LAS unsigned char*, int, int) const {}
    __device__ __forceinline__ void a_rows_lds(const Unit&, const LAS unsigned char*, unsigned (&)[2][2]) const {}
};
struct GroupedOrder {
    const char* A; const char* Bt; const int* tokl; const LAS int* tab; int NT, nN, G, c, KA, KB; size_t bexp;
    __device__ __forceinline__ bool next(int i, Unit& u) const {
        if (!tile_order(i, G, c, NT, nN, u.pm, u.pn)) return false;
        const int ts = tab[threadIdx.x & 31];
        const unsigned long long bal = __ballot(ts <= u.pm);
        const int e = __builtin_popcount((unsigned)bal) - 1;
        u.e = __builtin_amdgcn_readfirstlane(e); u.rt = u.pm - __builtin_amdgcn_readfirstlane(tab[u.e]); return true;
    }
    __device__ __forceinline__ const char* a_base(const Unit& u) const { return tokl ? A : A + (size_t)u.pm * BM * KA; }
    __device__ __forceinline__ const char* b_base(const Unit& u) const { return Bt + (size_t)u.e * bexp + (size_t)u.pn * BM * KB; }
    __device__ __forceinline__ void a_rows(const Unit& u, unsigned (&gv)[2][2]) const {
        const int ce = __builtin_amdgcn_readfirstlane(tab[32 + u.e]);
#pragma unroll
        for (int h = 0; h < 2; ++h)
#pragma unroll
            for (int i = 0; i < 2; ++i) { int R, C; stage_rc((int)threadIdx.x * 16 + i * 8192, R, C);
                const int pos = u.rt * BM + h * HALF + R; const int tok = pos < ce ? tokl[u.e * NTOK + pos] : 0; gv[h][i] = (unsigned)tok * (unsigned)KA + (unsigned)(C * 2); }
    }
    __device__ __forceinline__ void a_rows_stage(const Unit& u, LAS unsigned char* slot, int wid, int lane) const {
        if (wid == 2) __builtin_amdgcn_global_load_lds((const unsigned*)(tokl + (size_t)u.e * NTOK + u.rt * BM + 4 * lane), (LAS unsigned*)slot, 16, 0, 0);
    }
    __device__ __forceinline__ void a_rows_lds(const Unit& u, const LAS unsigned char* slot, unsigned (&gv)[2][2]) const {
        const int ce = __builtin_amdgcn_readfirstlane(tab[32 + u.e]);
#pragma unroll
        for (int h = 0; h < 2; ++h)
#pragma unroll
            for (int i = 0; i < 2; ++i) { int R, C; stage_rc((int)threadIdx.x * 16 + i * 8192, R, C);
                const int pl = h * HALF + R; const int tv = ((const LAS int*)slot)[pl]; const int tok = (u.rt * BM + pl) < ce ? tv : 0; gv[h][i] = (unsigned)tok * (unsigned)KA + (unsigned)(C * 2); }
    }
};

__device__ __forceinline__ unsigned cvt_pk_bf16(float lo, float hi) { unsigned r; asm volatile("v_cvt_pk_bf16_f32 %0, %1, %2" : "=v"(r) : "v"(lo), "v"(hi)); return r; }

typedef int v8i32 __attribute__((ext_vector_type(8)));
typedef unsigned u32x8 __attribute__((ext_vector_type(8)));
template <bool GATHER, bool FP8, class Epi, class Sched, bool ALIGN_EPI>
__device__ __forceinline__ void gemm_phase(LAS unsigned char* lds, const int KB, const Sched& S, const Epi& E) {
    const int tid = threadIdx.x, wid = __builtin_amdgcn_readfirstlane(tid >> 6), lane = tid & 63, wr = wid >> 2, wc = wid & 3, fr = lane & 15, fq = lane >> 4;
    const int nt = KB / 128;
    unsigned voffA[2], voffB[2];
#pragma unroll
    for (int i = 0; i < 2; ++i) { int R, C; stage_rc(tid * 16 + i * 8192, R, C);
        const int Rb = (int)Epi::PERM == 3 ? (64 * (R >> 5) + 16 * ((R & 15) >> 2) + 4 * ((R >> 4) & 1) + (((R & 1) << 1) | ((R >> 1) & 1))) : (int)Epi::PERM == 2 ? (64 * (R >> 5) + 16 * ((R & 15) >> 2) + 4 * ((R >> 4) & 1) + (R & 3)) : (int)Epi::PERM == 1 ? ((R & ~31) + perm32(R & 31)) : R;
        voffA[i] = (unsigned)(R * KB + C * 2); voffB[i] = (unsigned)(Rb * KB + C * 2); }
    const size_t kstep = (size_t)(BK * 2);
    const size_t hstep = (size_t)HALF * KB;
    const size_t hstepA = GATHER ? (size_t)0 : hstep;
    const size_t hstepB = (int)Epi::PERM >= 2 ? (size_t)8 * KB : hstep;
    const unsigned ldsw = (unsigned)wid * 1024u;
    const int aoff = lds_byte(wr * 64 + fr, fq * 8), boff = lds_byte(wc * 32 + fr, fq * 8);
#define PG8_SA(b, h) (((b) * 2 + (h)) * HTB)
#define PG8_SB(b, h) ((4 + (b) * 2 + (h)) * HTB)
#define PG8_STAGE(bufoff, gbase, voff) do { _Pragma("unroll") for (int _i = 0; _i < 2; ++_i) \
        __builtin_amdgcn_global_load_lds((const unsigned*)((const char*)(gbase) + (voff)[_i]), (LAS unsigned*)(lds + (bufoff) + ldsw + _i * 8192), 16, 0, 0); } while (0)
#define PG8_STAGE_A(bufoff, gbase, h, gvsel) do { if constexpr (GATHER) { PG8_STAGE(bufoff, gbase, gvsel[h]); } else { PG8_STAGE(bufoff, gbase, voffA); } } while (0)
#define PG8_LD32(addr) (u32x8)__builtin_shufflevector(*(const LAS u32x4*)(addr), *(const LAS u32x4*)((addr) + 1024), 0, 1, 2, 3, 4, 5, 6, 7)
#define PG8_LDA(dst, b, h) do { if constexpr (FP8) { _Pragma("unroll") for (int m = 0; m < 4; ++m) dst##8[m] = PG8_LD32(lds + PG8_SA(b, h) + aoff + m * 2048); } \
    else { _Pragma("unroll") for (int m = 0; m < 4; ++m) _Pragma("unroll") for (int k = 0; k < 2; ++k) dst[m][k] = *(const LAS bf16x8*)(lds + PG8_SA(b, h) + aoff + m * 2048 + k * 1024); } } while (0)
#define PG8_LDB(dst, b, h) do { if constexpr (FP8) { _Pragma("unroll") for (int n = 0; n < 2; ++n) dst##8[n] = PG8_LD32(lds + PG8_SB(b, h) + boff + n * 2048); } \
    else { _Pragma("unroll") for (int n = 0; n < 2; ++n) _Pragma("unroll") for (int k = 0; k < 2; ++k) dst[n][k] = *(const LAS bf16x8*)(lds + PG8_SB(b, h) + boff + n * 2048 + k * 1024); } } while (0)
#define PG8_MMA(ai, bj, At, Bt) do { __builtin_amdgcn_s_setprio(1); if constexpr (FP8) { _Pragma("unroll") for (int m = 0; m < 4; ++m) _Pragma("unroll") for (int n = 0; n < 2; ++n) \
        asm volatile("v_mfma_f32_16x16x128_f8f6f4 %0, %1, %2, %0" : "+v"(acc[ai][bj][m][n]) : "v"(Bt##8[n]), "v"(At##8[m])); } \
    else { _Pragma("unroll") for (int m = 0; m < 4; ++m) _Pragma("unroll") for (int n = 0; n < 2; ++n) _Pragma("unroll") for (int k = 0; k < 2; ++k) \
        acc[ai][bj][m][n] = __builtin_amdgcn_mfma_f32_16x16x32_bf16(Bt[n][k], At[m][k], acc[ai][bj][m][n], 0, 0, 0); } __builtin_amdgcn_s_setprio(0); } while (0)
#define PG8_MMAZ(ai, bj, At, Bt, z) do { if constexpr (FP8) { if (z) { __builtin_amdgcn_s_setprio(1); _Pragma("unroll") for (int m = 0; m < 4; ++m) _Pragma("unroll") for (int n = 0; n < 2; ++n) \
        asm volatile("v_mfma_f32_16x16x128_f8f6f4 %0, %1, %2, 0" : "=&v"(acc[ai][bj][m][n]) : "v"(Bt##8[n]), "v"(At##8[m])); __builtin_amdgcn_s_setprio(0); } else PG8_MMA(ai, bj, At, Bt); } else PG8_MMA(ai, bj, At, Bt); } while (0)
#define PG8_WAIT_V(n) asm volatile("s_waitcnt vmcnt(" #n ")" ::: "memory")
#define PG8_WAIT_L(n) asm volatile("s_waitcnt lgkmcnt(" #n ")" ::: "memory")
#define PG8_BAR __builtin_amdgcn_s_barrier()
#define PG8_SCHED __builtin_amdgcn_sched_barrier(0)
    Unit cur, nxt; int ui = 0;
    if (!S.next(0, cur)) return;
    f32x4 acc[2][2][4][2];
    if constexpr (!FP8) {
#pragma unroll
    for (int a = 0; a < 2; ++a)
#pragma unroll
        for (int b = 0; b < 2; ++b)
#pragma unroll
            for (int m = 0; m < 4; ++m)
#pragma unroll
                for (int n = 0; n < 2; ++n) acc[a][b][m][n] = (f32x4){0.f, 0.f, 0.f, 0.f};
    }
    bf16x8 At[4][2], B0[2][2], B1[2][2]; u32x8 At8[4], B08[2], B18[2];
    const char* cA = S.a_base(cur); const char* cB = S.b_base(cur);
    unsigned gvc[2][2] = {{0u, 0u}, {0u, 0u}};
    LAS unsigned char* tslot = lds + EPI_SLOT_OFF + 4096;
    if constexpr (GATHER) S.a_rows(cur, gvc);
    PG8_STAGE(PG8_SB(0, 0), cB, voffB); PG8_STAGE(PG8_SB(0, 1), cB + hstepB, voffB); PG8_STAGE_A(PG8_SA(0, 0), cA, 0, gvc); PG8_STAGE_A(PG8_SA(0, 1), cA + hstepA, 1, gvc);
    if (wr == 1) PG8_BAR;
    PG8_WAIT_V(2); PG8_BAR;
    PG8_STAGE(PG8_SB(1, 0), cB + kstep, voffB); PG8_STAGE_A(PG8_SA(1, 0), cA + kstep, 0, gvc); PG8_STAGE(PG8_SB(1, 1), cB + hstepB + kstep, voffB);
    PG8_WAIT_V(6); PG8_BAR;
    for (;;) {
        const bool has_next = S.next(ui + 1, nxt);
        const char* nA = has_next ? S.a_base(nxt) : cA; const char* nB = has_next ? S.b_base(nxt) : cB;
        if constexpr (GATHER) { if (has_next) S.a_rows_stage(nxt, tslot, wid, lane); }
        LAS unsigned char* eslot = lds + EPI_SLOT_OFF + (ui & 1) * 2048;
        E.stage(cur, eslot, wid, lane);
#pragma unroll 1
        for (int t = 0; t < nt; t += 2) {
            const bool last = (t == nt - 2), first = (t == 0);
            const char* a1 = cA + (size_t)(t + 1) * kstep;
            const char* a2 = last ? nA : cA + (size_t)(t + 2) * kstep; const char* b2 = last ? nB : cB + (size_t)(t + 2) * kstep;
            const char* a3 = a2 + kstep; const char* b3 = b2 + kstep;
            PG8_LDB(B0, 0, 0); PG8_LDB(B1, 0, 1); PG8_SCHED; PG8_LDA(At, 0, 0); PG8_STAGE_A(PG8_SA(1, 1), a1 + hstepA, 1, gvc);
            if constexpr (GATHER) { if (last && has_next) S.a_rows_lds(nxt, tslot, gvc); }
            PG8_WAIT_V(8); PG8_WAIT_L(0); PG8_BAR; PG8_MMAZ(0, 0, At, B0, first); PG8_MMAZ(0, 1, At, B1, first); PG8_BAR; PG8_SCHED;
            PG8_LDA(At, 0, 1); PG8_STAGE(PG8_SB(0, 0), b2, voffB); PG8_STAGE(PG8_SB(0, 1), b2 + hstepB, voffB); PG8_STAGE_A(PG8_SA(0, 0), a2, 0, gvc);
            PG8_WAIT_V(8); PG8_WAIT_L(0); PG8_BAR; PG8_MMAZ(1, 0, At, B0, first); PG8_MMAZ(1, 1, At, B1, first); PG8_BAR; PG8_SCHED;
            PG8_LDB(B0, 1, 0); PG8_LDB(B1, 1, 1); PG8_SCHED; PG8_LDA(At, 1, 0); PG8_STAGE_A(PG8_SA(0, 1), a2 + hstepA, 1, gvc);
            PG8_WAIT_V(8); PG8_WAIT_L(0); PG8_BAR; PG8_MMA(0, 0, At, B0); PG8_MMA(0, 1, At, B1); PG8_BAR; PG8_SCHED;
            PG8_LDA(At, 1, 1); PG8_STAGE(PG8_SB(1, 0), b3, voffB); PG8_STAGE(PG8_SB(1, 1), b3 + hstepB, voffB); PG8_STAGE_A(PG8_SA(1, 0), a3, 0, gvc);
            PG8_WAIT_V(8); PG8_WAIT_L(0); PG8_BAR; PG8_MMA(1, 0, At, B0); PG8_MMA(1, 1, At, B1); PG8_BAR; PG8_SCHED;
        }
        if constexpr (ALIGN_EPI) { if (wr == 0) PG8_BAR; }
        if constexpr (FP8) asm volatile("s_nop 15\n\ts_nop 15" ::: "memory");
        E(acc, cur, wr, wc, fr, fq, eslot);
        if (!has_next) break;
        if constexpr (!FP8)
#pragma unroll
        for (int a = 0; a < 2; ++a)
#pragma unroll
            for (int b = 0; b < 2; ++b)
#pragma unroll
                for (int m = 0; m < 4; ++m)
#pragma unroll
                    for (int n = 0; n < 2; ++n) acc[a][b][m][n] = (f32x4){0.f, 0.f, 0.f, 0.f};
        cur = nxt; cA = nA; cB = nB; ++ui;
        if constexpr (ALIGN_EPI) { if (wr == 1) PG8_BAR; }
    }
    PG8_WAIT_V(0);
    if constexpr (!ALIGN_EPI) { if (wr == 0) PG8_BAR; }
    PG8_BAR;
#undef PG8_SA
#undef PG8_SB
#undef PG8_STAGE
#undef PG8_STAGE_A
#undef PG8_LDA
#undef PG8_LDB
#undef PG8_MMA
#undef PG8_MMAZ
#undef PG8_LD32
#undef PG8_WAIT_V
#undef PG8_WAIT_L
#undef PG8_BAR
#undef PG8_SCHED
}

typedef _Float16 h16x8 __attribute__((ext_vector_type(8)));
struct EpiQKV {
    static constexpr int PERM = 1;
    bf16_t* QKV; const float* bias; const _Float16* RC; const _Float16* RS;
    __device__ __forceinline__ void stage(const Unit& u, LAS unsigned char* slot, int wid, int lane) const {
        if (wid == 0) __builtin_amdgcn_global_load_lds((const unsigned*)(bias + u.pn * BM + 4 * lane), (LAS unsigned*)slot, 16, 0, 0);
    }
    __device__ __forceinline__ void operator()(const f32x4 (&acc)[2][2][4][2], const Unit& u, int wr, int wc, int fr, int fq, const LAS unsigned char* slot) const {
        const int hs = u.pn * 4 + wc; const bool rope = (hs < 16) || (hs >= 24 && hs < 34); const float sc = (hs < 8 || (hs >= 24 && hs < 32)) ? QSCALE : 1.0f;
        const LAS float* bsl = (const LAS float*)slot + wc * 64 + 8 * fq;
        h16x8 cs[2][4], sn[2][4];
#pragma unroll
        for (int ai = 0; ai < 2; ++ai)
#pragma unroll
            for (int m = 0; m < 4; ++m) { const size_t t = (size_t)(u.pm * BM + ai * HALF + wr * 64 + m * 16 + fr);
                if (rope) { cs[ai][m] = *(const h16x8*)(RC + t * 32 + 8 * fq); sn[ai][m] = *(const h16x8*)(RS + t * 32 + 8 * fq); }
                else {
#pragma unroll
                    for (int j = 0; j < 8; ++j) { cs[ai][m][j] = (_Float16)1.0f; sn[ai][m][j] = (_Float16)0.0f; } } }
        asm volatile("" ::: "memory");
#pragma unroll
        for (int ai = 0; ai < 2; ++ai) {
#pragma unroll
            for (int m = 0; m < 4; ++m) { const int t = u.pm * BM + ai * HALF + wr * 64 + m * 16 + fr;
                f32x4 o1[2], o2[2];
#pragma unroll
                for (int n = 0; n < 2; ++n) { const f32x4 v1 = acc[ai][0][m][n] + *(const LAS f32x4*)(bsl + 4 * n), v2 = acc[ai][1][m][n] + *(const LAS f32x4*)(bsl + 32 + 4 * n);
                    const f32x4 c = {(float)cs[ai][m][4 * n], (float)cs[ai][m][4 * n + 1], (float)cs[ai][m][4 * n + 2], (float)cs[ai][m][4 * n + 3]};
                    const f32x4 sv = {(float)sn[ai][m][4 * n], (float)sn[ai][m][4 * n + 1], (float)sn[ai][m][4 * n + 2], (float)sn[ai][m][4 * n + 3]};
                    o1[n] = (v1 * c - v2 * sv) * sc; o2[n] = (v2 * c + v1 * sv) * sc; }
                u32x4 w1, w2; w1.x = cvt_pk_bf16(o1[0][0], o1[0][1]); w1.y = cvt_pk_bf16(o1[0][2], o1[0][3]); w1.z = cvt_pk_bf16(o1[1][0], o1[1][1]); w1.w = cvt_pk_bf16(o1[1][2], o1[1][3]);
                w2.x = cvt_pk_bf16(o2[0][0], o2[0][1]); w2.y = cvt_pk_bf16(o2[0][2], o2[0][3]); w2.z = cvt_pk_bf16(o2[1][0], o2[1][1]); w2.w = cvt_pk_bf16(o2[1][2], o2[1][3]);
                const bool lo8 = fr < 8; u32x4 snd, rcv;
                snd.x = lo8 ? w2.x : w1.x; snd.y = lo8 ? w2.y : w1.y; snd.z = lo8 ? w2.z : w1.z; snd.w = lo8 ? w2.w : w1.w;
                rcv.x = (unsigned)__builtin_amdgcn_update_dpp(0, (int)snd.x, 0x128, 0xF, 0xF, false); rcv.y = (unsigned)__builtin_amdgcn_update_dpp(0, (int)snd.y, 0x128, 0xF, 0xF, false);
                rcv.z = (unsigned)__builtin_amdgcn_update_dpp(0, (int)snd.z, 0x128, 0xF, 0xF, false); rcv.w = (unsigned)__builtin_amdgcn_update_dpp(0, (int)snd.w, 0x128, 0xF, 0xF, false);
                u32x4 dA, dB; dA.x = lo8 ? w1.x : rcv.x; dA.y = lo8 ? w1.y : rcv.y; dA.z = lo8 ? w1.z : rcv.z; dA.w = lo8 ? w1.w : rcv.w;
                dB.x = lo8 ? rcv.x : w2.x; dB.y = lo8 ? rcv.y : w2.y; dB.z = lo8 ? rcv.z : w2.z; dB.w = lo8 ? rcv.w : w2.w;
                bf16_t* dst = QKV + ((size_t)hs * NTOK + (t - fr + (fr & 7))) * 64 + (lo8 ? 0 : 32) + 8 * fq;
                *(u32x4*)dst = dA; *(u32x4*)(dst + 8 * 64) = dB; }
        }
    }
};
struct EpiOut {
    static constexpr int PERM = 1;
    const bf16_t* h1; const float* sr1; const float* g1; bf16_t* x1b; const float* bias; float oscale;
    __device__ __forceinline__ void stage(const Unit& u, LAS unsigned char* slot, int wid, int lane) const {
        if (wid == 0) __builtin_amdgcn_global_load_lds((const unsigned*)(sr1 + u.pm * BM + 4 * lane), (LAS unsigned*)slot, 16, 0, 0);
    }
    __device__ __forceinline__ void operator()(const f32x4 (&acc)[2][2][4][2], const Unit& u, int wr, int wc, int fr, int fq, const LAS unsigned char* slot) const {
        const int col0 = u.pn * BM + wc * 32 + 8 * fq;
        const LAS float* srp = (const LAS float*)slot + wr * 64 + fr;
        f32x4 bv[2][2], gi[2][2];
#pragma unroll
        for (int bj = 0; bj < 2; ++bj)
#pragma unroll
            for (int n = 0; n < 2; ++n) { bv[bj][n] = *(const f32x4*)(bias + col0 + bj * HALF + 4 * n); const f32x4 g = *(const f32x4*)(g1 + col0 + bj * HALF + 4 * n);
                gi[bj][n] = (f32x4){__builtin_amdgcn_rcpf(g[0]), __builtin_amdgcn_rcpf(g[1]), __builtin_amdgcn_rcpf(g[2]), __builtin_amdgcn_rcpf(g[3])}; }
#pragma unroll
        for (int ai = 0; ai < 2; ++ai) {
            u32x4 hv[4][2];
#pragma unroll
            for (int m = 0; m < 4; ++m) { const size_t off = (size_t)(u.pm * BM + ai * HALF + wr * 64 + m * 16 + fr) * DM + col0;
#pragma unroll
                for (int bj = 0; bj < 2; ++bj) hv[m][bj] = __builtin_nontemporal_load((const u32x4*)(h1 + off + bj * HALF)); }
            asm volatile("" ::: "memory");
#pragma unroll
            for (int m = 0; m < 4; ++m) { const size_t off = (size_t)(u.pm * BM + ai * HALF + wr * 64 + m * 16 + fr) * DM + col0; const float sr = srp[ai * HALF + m * 16];
#pragma unroll
                for (int bj = 0; bj < 2; ++bj) { const u32x4 h = hv[m][bj];
                    const f32x4 x0 = (f32x4){bflo(h.x), bfhi(h.x), bflo(h.y), bfhi(h.y)} * (gi[bj][0] * sr), x1 = (f32x4){bflo(h.z), bfhi(h.z), bflo(h.w), bfhi(h.w)} * (gi[bj][1] * sr);
                    const f32x4 v0 = x0 + acc[ai][bj][m][0] * oscale + bv[bj][0], v1 = x1 + acc[ai][bj][m][1] * oscale + bv[bj][1];
                    u32x4 w; w.x = cvt_pk_bf16(v0[0], v0[1]); w.y = cvt_pk_bf16(v0[2], v0[3]); w.z = cvt_pk_bf16(v1[0], v1[1]); w.w = cvt_pk_bf16(v1[2], v1[3]);
                    *(u32x4*)(x1b + off + bj * HALF) = w; } }
        }
    }
};
typedef float f32x2 __attribute__((ext_vector_type(2)));
struct EpiSwiglu {
    static constexpr int PERM = 3;
    unsigned char* HID; const float* b1; const float* rsl; float oscale;
    __device__ __forceinline__ void stage(const Unit& u, LAS unsigned char* slot, int wid, int lane) const {
        if (wid == 0) __builtin_amdgcn_global_load_lds((const unsigned*)(b1 + (size_t)u.e * DU + u.pn * BM + 4 * lane), (LAS unsigned*)slot, 16, 0, 0);
        if (wid == 1) __builtin_amdgcn_global_load_lds((const unsigned*)(rsl + (size_t)u.e * NTOK + u.rt * BM + 4 * lane), (LAS unsigned*)(slot + 1024), 16, 0, 0);
    }
    __device__ __forceinline__ void operator()(const f32x4 (&acc)[2][2][4][2], const Unit& u, int wr, int wc, int fr, int fq, const LAS unsigned char* slot) const {
        const int uc0 = u.pn * BM + wc * 64 + 16 * fq;
        const LAS float* bsl = (const LAS float*)slot + wc * 64 + 16 * fq; const LAS float* rsp = (const LAS float*)(slot + 1024) + wr * 64 + fr;
        f32x4 bv[2][2];
#pragma unroll
        for (int bj = 0; bj < 2; ++bj)
#pragma unroll
            for (int n = 0; n < 2; ++n) { const f32x4 b = *(const LAS f32x4*)(bsl + 8 * bj + 4 * n); bv[bj][n] = (f32x4){b[0], b[2], __builtin_fmaf(b[1], HID_FP8_SCALE, HID_FP8_SCALE), __builtin_fmaf(b[3], HID_FP8_SCALE, HID_FP8_SCALE)}; }
#pragma unroll
        for (int ai = 0; ai < 2; ++ai)
#pragma unroll
            for (int m = 0; m < 4; ++m) { f32x2 hv[4]; const float rs = rsp[ai * HALF + m * 16] * oscale, rss = rs * HID_FP8_SCALE; const f32x4 rs4 = (f32x4){rs, rs, rss, rss};
#pragma unroll
                for (int bj = 0; bj < 2; ++bj)
#pragma unroll
                    for (int n = 0; n < 2; ++n) { const f32x4 v = acc[ai][bj][m][n] * rs4 + bv[bj][n];
                        const f32x2 g = (f32x2){fminf(v[0], 7.0f), fminf(v[1], 7.0f)};
                        const f32x2 l = (f32x2){__builtin_amdgcn_fmed3f(v[2], -6.0f * HID_FP8_SCALE, 8.0f * HID_FP8_SCALE), __builtin_amdgcn_fmed3f(v[3], -6.0f * HID_FP8_SCALE, 8.0f * HID_FP8_SCALE)};
                        const f32x2 t = g * (-1.702f * LOG2E);
                        const f32x2 d = (f32x2){__builtin_amdgcn_exp2f(t[0]), __builtin_amdgcn_exp2f(t[1])} + 1.0f;
                        const f32x2 r = (f32x2){__builtin_amdgcn_rcpf(d[0]), __builtin_amdgcn_rcpf(d[1])};
                        hv[2 * bj + n] = (g * r) * l; }
                u32x2 w; w.x = pk4_fp8(hv[0][0], hv[0][1], hv[1][0], hv[1][1]); w.y = pk4_fp8(hv[2][0], hv[2][1], hv[3][0], hv[3][1]);
                *(u32x2*)(HID + (size_t)(u.pm * BM + ai * HALF + wr * 64 + m * 16 + fr) * DFF + (uc0 >> 1)) = w; }
    }
};
struct EpiY {
    static constexpr int PERM = 2;
    unsigned char* Y; const float* b2; float oscale;
    __device__ __forceinline__ void stage(const Unit& u, LAS unsigned char* slot, int wid, int lane) const {
        if (wid == 0) __builtin_amdgcn_global_load_lds((const unsigned*)(b2 + (size_t)u.e * DM + u.pn * BM + 4 * lane), (LAS unsigned*)slot, 16, 0, 0);
    }
    __device__ __forceinline__ void operator()(const f32x4 (&acc)[2][2][4][2], const Unit& u, int wr, int wc, int fr, int fq, const LAS unsigned char* slot) const {
        const int col0 = u.pn * BM + wc * 64 + 16 * fq;
        const LAS float* bsl = (const LAS float*)slot + wc * 64 + 16 * fq;
        f32x4 bv[2][2];
#pragma unroll
        for (int bj = 0; bj < 2; ++bj)
#pragma unroll
            for (int n = 0; n < 2; ++n) bv[bj][n] = *(const LAS f32x4*)(bsl + 8 * bj + 4 * n) * Y_FP8_SCALE;
        const float os = oscale * Y_FP8_SCALE;
#pragma unroll
        for (int ai = 0; ai < 2; ++ai)
#pragma unroll
            for (int m = 0; m < 4; ++m) { u32x4 w;
                { const f32x4 v = acc[ai][0][m][0] * os + bv[0][0]; w.x = pk4_fp8(v[0], v[1], v[2], v[3]); }
                { const f32x4 v = acc[ai][0][m][1] * os + bv[0][1]; w.y = pk4_fp8(v[0], v[1], v[2], v[3]); }
                { const f32x4 v = acc[ai][1][m][0] * os + bv[1][0]; w.z = pk4_fp8(v[0], v[1], v[2], v[3]); }
                { const f32x4 v = acc[ai][1][m][1] * os + bv[1][1]; w.w = pk4_fp8(v[0], v[1], v[2], v[3]); }
                *(u32x4*)(Y + (size_t)(u.pm * BM + ai * HALF + wr * 64 + m * 16 + fr) * DM + col0) = w; }
    }
};
}

#define GAS __attribute__((address_space(1)))
typedef GAS unsigned gu32;
#define RLX_AGENT __ATOMIC_RELAXED, __HIP_MEMORY_SCOPE_AGENT
#define XB_TMO      128
#define XB_XCNT(j)  (256  + 64 * (j))
#define XB_XSUB(j)  (1280 + 64 * (j))
#define XB_XGEN(j)  (2304 + 64 * (j))
#define XB_TOP      3328
#define XB_TOPGEN   3392
#define XCD_BAR_WORDS 3456
#define XB_SPIN_CAP (1u << 18)

__device__ __forceinline__ unsigned xb_ld(unsigned* p)              { return __hip_atomic_load(p, __ATOMIC_RELAXED, __HIP_MEMORY_SCOPE_AGENT); }
__device__ __forceinline__ unsigned xb_add(unsigned* p, unsigned v) { return __hip_atomic_fetch_add(p, v, __ATOMIC_RELAXED, __HIP_MEMORY_SCOPE_AGENT); }
__device__ __forceinline__ unsigned xb_xcc_id() { return (unsigned)__builtin_amdgcn_s_getreg((3 << 11) | 20) & 0xFu; }
#define XB_SPIN(cond, bar) do { unsigned _sp = 0; while (cond) { __builtin_amdgcn_s_sleep(1); \
    if ((++_sp & 255u) == 0u) { if (xb_ld(&(bar)[XB_TMO])) break; if (_sp > XB_SPIN_CAP) { atomicAdd(&(bar)[XB_TMO], 1u); break; } } } } while (0)

struct XcdBarrier {
    unsigned* bar; unsigned x;
    volatile LAS unsigned* st;
};

__device__ __forceinline__ XcdBarrier xcd_barrier_post(unsigned* bar, volatile LAS unsigned* st) {
    XcdBarrier b; b.bar = bar; b.x = xb_xcc_id(); b.st = st;
    if (threadIdx.x == 0) (void)xb_add(&bar[XB_XCNT(b.x)], 1u);
    return b;
}
__device__ __forceinline__ void xcd_barrier_complete(unsigned* bar, unsigned x, unsigned& nloc, unsigned& nx) {
    const unsigned G = gridDim.x * gridDim.y * gridDim.z;
    unsigned sum, cnt, mine, sp = 0u;
    for (;;) {
        sum = 0u; cnt = 0u; mine = 0u;
#pragma unroll
        for (unsigned j = 0; j < 16; ++j) { const unsigned c = xb_ld(&bar[XB_XCNT(j)]); sum += c; cnt += (c > 0u) ? 1u : 0u; mine = (j == x) ? c : mine; }
        if (sum == G) break;
        __builtin_amdgcn_s_sleep(1);
        if ((++sp & 255u) == 0u) { if (xb_ld(&bar[XB_TMO])) break; if (sp > XB_SPIN_CAP) { atomicAdd(&bar[XB_TMO], 1u); break; } }
    }
    nloc = mine > 0u ? mine : 1u; nx = cnt > 0u ? cnt : 1u;
}

__device__ __forceinline__ void xcd_barrier(const XcdBarrier& b) {
    asm volatile("s_waitcnt vmcnt(0)" ::: "memory");
    __syncthreads();
    if (threadIdx.x == 0) {
        unsigned* bar = b.bar;
        __builtin_amdgcn_s_waitcnt(0);
        unsigned nloc = b.st[0], nx = b.st[1];
        if (nloc == 0u) { xcd_barrier_complete(bar, b.x, nloc, nx); b.st[0] = nloc; b.st[1] = nx; }
        const unsigned round = b.st[2]; b.st[2] = round + 1u;
        const unsigned old = xb_add(&bar[XB_XSUB(b.x)], 1u);
        const unsigned gen = old / nloc;
        if (old + 1u == (gen + 1u) * nloc) {
            __builtin_amdgcn_fence(__ATOMIC_RELEASE, "agent");
            asm volatile("s_waitcnt vmcnt(0)" ::: "memory");
            (void)xb_add(&bar[XB_TOP], 1u);
        }
        const unsigned target = (round + 1u) * nx;
        XB_SPIN(xb_ld(&bar[XB_TOP]) < target, bar);
        __builtin_amdgcn_fence(__ATOMIC_ACQUIRE, "agent");
        asm volatile("s_waitcnt vmcnt(0)" ::: "memory");
    }
    __syncthreads();
}


__device__ __forceinline__ int expert_table_lds(const unsigned* cnt, LAS int* tab, int lane, int wave) {
    int mycnt, myts; expert_tiles(cnt, lane, mycnt, myts);
    if (wave == 0 && lane < 32) { tab[lane] = myts; tab[32 + lane] = mycnt; }
    __syncthreads();
    return __builtin_amdgcn_readfirstlane(__shfl(myts, 31) + ((__shfl(mycnt, 31) + 255) >> 8));
}

constexpr int NWAVES = 8;
constexpr int LDS_BYTES = 147456;
constexpr int MISC_OFF = 131072 + 320;
constexpr int TAB_OFF = 131072 + 10240;
constexpr int CW_BAR = 4096;
#ifndef MK_N_LAUNCHES
#define MK_N_LAUNCHES 1
#endif
constexpr int N_PHASES = 9;
struct Args { Params P; int ph_lo, ph_hi; };

__global__ void __launch_bounds__(NWAVES * 64, 2) mk_fwd(Args args) {
    extern __shared__ __attribute__((aligned(16))) unsigned char lds[];
    const Params& P = args.P;
    const int tid = threadIdx.x, lane = tid & 63, wave = __builtin_amdgcn_readfirstlane(tid >> 6);
    const int gw = blockIdx.x * NWAVES + wave, ngw = gridDim.x * NWAVES;
    volatile LAS unsigned* MISC = (volatile LAS unsigned*)((LAS unsigned char*)lds + MISC_OFF);
    for (int u = tid; u < 64; u += NWAVES * 64) MISC[u] = 0u;
    __syncthreads();
    XcdBarrier bar; bar.bar = (unsigned*)(P.ws + WS_CTL) + CW_BAR; bar.x = 0; bar.st = nullptr;
    const int lo = args.ph_lo, hi = args.ph_hi;
    if (hi - lo > 1) bar = xcd_barrier_post((unsigned*)(P.ws + WS_CTL) + CW_BAR, MISC + 8);
#define IN(k) (lo <= (k) && (k) < hi)
#define SEAM(k) do { if (IN(k) && IN((k) + 1)) xcd_barrier(bar); } while (0)
#define RUN(k, ...) do { if (IN(k)) { __VA_ARGS__; } } while (0)
    const bool split_p1 = (gridDim.x == 256) && IN(0) && IN(1);
    constexpr int CONV_Y0 = 24, TI_P0X = 16000, TI_P0 = TI_IN + TI_OUT + TI_P0X;
    RUN(0, p0_prologue(P, gw, ngw, lane, (LAS float*)lds + wave * (64 * 36), split_p1 ? TI_P0 : TI_ALL));
    SEAM(0);
    RUN(1, {
        const int xl = (int)blockIdx.x & 7, yl = (int)blockIdx.x >> 3;
        if (split_p1 && yl >= CONV_Y0) weight_items(P, TI_P0, TI_ALL, ((yl - CONV_Y0) * 8 + xl) * NWAVES + wave, (32 - CONV_Y0) * 8 * NWAVES, lane, (LAS float*)lds + wave * (64 * 36));
        else {
            pg8::DenseOrder S; S.init(P.ws + WS_H1, P.ws + WS_WIN, NTOK, D_IN, DM * 2, split_p1 ? CONV_Y0 * 8 : (int)gridDim.x, split_p1 ? yl * 8 + xl : (int)blockIdx.x);
            const _Float16* RC = (const _Float16*)(P.ws + WS_ROPE);
            pg8::EpiQKV E{(bf16_t*)(P.ws + WS_QKV), P.b_in, RC, RC + (size_t)NTOK * 32};
            pg8::gemm_phase<false, false, pg8::EpiQKV, pg8::DenseOrder, true>((LAS unsigned char*)lds, DM * 2, S, E);
        }
    });
    SEAM(1);
    RUN(2, att::attn_phase(P, (LAS unsigned char*)lds, tid, lane, wave));
    SEAM(2);
    RUN(3, p2b_merge(P, gw, ngw, lane));
    SEAM(3);
    RUN(4, {
        pg8::DenseOrder S; S.init(P.ws + WS_MIXED, P.ws + WS_WOUT, NTOK, DM, DM, (int)gridDim.x, (int)blockIdx.x);
        pg8::EpiOut E{(const bf16_t*)(P.ws + WS_H1), (const float*)(P.ws + WS_SR1), P.g1, (bf16_t*)(P.ws + WS_X1B), P.b_out, 1.0f / (W_FP8_SCALE * MIX_FP8_SCALE)};
        pg8::gemm_phase<false, true, pg8::EpiOut, pg8::DenseOrder, true>((LAS unsigned char*)lds, DM, S, E);
    });
    SEAM(4);
    RUN(5, route::route_phase(P, (LAS unsigned char*)lds, tid, lane, wave));
    SEAM(5);
    RUN(6, {
        LAS int* tab = (LAS int*)((LAS unsigned char*)lds + TAB_OFF);
        const int NT = expert_table_lds((const unsigned*)(P.ws + WS_CTL) + CW_CNT, tab, lane, wave);
        pg8::GroupedOrder S{(const char*)(P.ws + WS_H2), (const char*)(P.ws + WS_W1), (const int*)(P.ws + WS_TOKL), tab, NT, DU / 256, (int)gridDim.x, (int)blockIdx.x, DM, DM, (size_t)DU * DM};
        pg8::EpiSwiglu E{(unsigned char*)(P.ws + WS_HID), P.b1, (const float*)(P.ws + WS_RSL), 1.0f / (W_FP8_SCALE * H2_FP8_SCALE)};
        pg8::gemm_phase<true, true, pg8::EpiSwiglu, pg8::GroupedOrder, true>((LAS unsigned char*)lds, DM, S, E);
    });
    SEAM(6);
    RUN(7, {
        LAS int* tab = (LAS int*)((LAS unsigned char*)lds + TAB_OFF);
        const int NT = expert_table_lds((const unsigned*)(P.ws + WS_CTL) + CW_CNT, tab, lane, wave);
        pg8::GroupedOrder S{(const char*)(P.ws + WS_HID), (const char*)(P.ws + WS_W2), nullptr, tab, NT, DM / 256, (int)gridDim.x, (int)blockIdx.x, DFF, DFF, (size_t)DM * DFF};
        pg8::EpiY E{(unsigned char*)(P.ws + WS_Y), P.b2, 1.0f / (W_FP8_SCALE * HID_FP8_SCALE)};
        pg8::gemm_phase<false, true, pg8::EpiY, pg8::GroupedOrder, true>((LAS unsigned char*)lds, DFF, S, E);
    });
    SEAM(7);
    RUN(8, p7_combine(P, gw, ngw, lane, P.out));
#undef IN
#undef SEAM
#undef RUN
}

extern "C" void kernel_launch(void* const* d_in, const int* in_sizes, int n_in, void* d_out, int out_size, void* d_ws, size_t ws_size, hipStream_t stream) {
    static int grid = 0;
    if (grid == 0) {
        if (n_in != 18 || out_size != NTOK * DM || ws_size < WS_END) { fprintf(stderr, "kernel_launch: unexpected shapes (n_in %d out %d ws %zu)\n", n_in, out_size, ws_size); grid = -1; return; }
        int dev = 0, cus = 0, per_cu = 0;
        if (hipGetDevice(&dev) != hipSuccess || hipDeviceGetAttribute(&cus, hipDeviceAttributeMultiprocessorCount, dev) != hipSuccess) { fprintf(stderr, "kernel_launch: device query failed\n"); grid = -1; return; }
        if (hipFuncSetAttribute((const void*)mk_fwd, hipFuncAttributeMaxDynamicSharedMemorySize, LDS_BYTES) != hipSuccess) { fprintf(stderr, "kernel_launch: hipFuncSetAttribute failed\n"); grid = -1; return; }
        if (hipOccupancyMaxActiveBlocksPerMultiprocessor(&per_cu, (const void*)mk_fwd, NWAVES * 64, LDS_BYTES) != hipSuccess || per_cu < 1) { fprintf(stderr, "kernel_launch: occupancy query says %d blocks/CU; nothing launched\n", per_cu); (void)hipGetLastError(); grid = -1; return; }
        grid = cus;
    }
    if (grid < 0) return;
    Args a{};
    Params& P = a.P;
    P.x = (const float*)d_in[0]; P.pos = (const int*)d_in[1]; P.g1 = (const float*)d_in[2]; P.w_in = (const float*)d_in[3]; P.b_in = (const float*)d_in[4];
    P.sinks = (const float*)d_in[5]; P.gn_dil = (const float*)d_in[6]; P.gn_swa = (const float*)d_in[7]; P.w_out = (const float*)d_in[8]; P.b_out = (const float*)d_in[9];
    P.g2 = (const float*)d_in[10]; P.w_router = (const float*)d_in[11]; P.b_router = (const float*)d_in[12]; P.w1 = (const float*)d_in[13]; P.b1 = (const float*)d_in[14];
    P.w2 = (const float*)d_in[15]; P.b2 = (const float*)d_in[16]; P.gf = (const float*)d_in[17]; P.out = (float*)d_out; P.ws = (unsigned char*)d_ws;
    (void)hipMemsetAsync((char*)d_ws + WS_CTL, 0, CTL_BYTES, stream);
#if MK_N_LAUNCHES == 1
    a.ph_lo = 0; a.ph_hi = N_PHASES;
    hipLaunchKernelGGL(mk_fwd, dim3(grid), dim3(NWAVES * 64), LDS_BYTES, stream, a);
#else
    for (int k = 0; k < N_PHASES; ++k) { a.ph_lo = k; a.ph_hi = k + 1; hipLaunchKernelGGL(mk_fwd, dim3(grid), dim3(NWAVES * 64), LDS_BYTES, stream, a); }
#endif
}
```

```cpp
#include <hip/hip_runtime.h>
#include <cstdio>
#include <cstdint>

#define LAS __attribute__((address_space(3)))
typedef unsigned short bf16_t;
typedef short bf16x8 __attribute__((ext_vector_type(8)));
typedef float f32x4 __attribute__((ext_vector_type(4)));
typedef unsigned u32x4 __attribute__((ext_vector_type(4)));
typedef unsigned u32x2 __attribute__((ext_vector_type(2)));

constexpr int BATCH = 8, SEQ = 4096, DM = 1024, NTOK = BATCH * SEQ;
constexpr int HD = 64, D_IN = 2304;
constexpr int NEXP = 32, DFF = 1024, DU = 2048;
constexpr float EPS = 1e-5f;
constexpr float LOG2E = 1.4426950408889634f;
constexpr float QSCALE = 0.125f * LOG2E;

constexpr size_t MiB = 1u << 20;
constexpr size_t WS_CTL = 0, CTL_BYTES = 32768;
constexpr size_t WS_WIN = 2 * MiB;
constexpr size_t WS_WRH = 7 * MiB;
constexpr size_t WS_WRL = 7 * MiB + 65536;
constexpr size_t WS_WOUT = 8 * MiB;
constexpr size_t WS_W1 = 16 * MiB;
constexpr size_t WS_W2 = 144 * MiB;
constexpr size_t WS_H1 = 208 * MiB;
constexpr size_t WS_QKV = 272 * MiB;
constexpr size_t WS_PART = 416 * MiB;
constexpr size_t WS_OSWA = 512 * MiB;
constexpr size_t WS_LSE = 544 * MiB;
constexpr size_t WS_MIXED = 548 * MiB;
constexpr size_t WS_H2 = 612 * MiB;
constexpr size_t WS_TOKL = 676 * MiB;
constexpr size_t WS_ASSIGN = 680 * MiB;
constexpr size_t WS_GATE = 680 * MiB + 512 * 1024;
constexpr size_t WS_HID = 682 * MiB;
constexpr size_t WS_ROPE = 954 * MiB;
constexpr size_t WS_RSL = 962 * MiB;
constexpr size_t WS_SR1 = 966 * MiB;
constexpr size_t WS_END = 967 * MiB;
constexpr size_t WS_X1B = 416 * MiB;
constexpr size_t WS_Y = 208 * MiB;
constexpr int CW_CNT = 1024;

struct Params {
    const float* x; const int* pos; const float* g1; const float* w_in; const float* b_in; const float* sinks;
    const float* gn_dil; const float* gn_swa; const float* w_out; const float* b_out; const float* g2;
    const float* w_router; const float* b_router; const float* w1; const float* b1; const float* w2; const float* b2; const float* gf;
    float* out; unsigned char* ws;
};

__device__ __forceinline__ unsigned f2bf(float f) { unsigned u = __builtin_bit_cast(unsigned, f); return (u + 0x7fffu + ((u >> 16) & 1u)) >> 16; }
__device__ __forceinline__ unsigned pk2(float lo, float hi) { return f2bf(lo) | (f2bf(hi) << 16); }
__device__ __forceinline__ float bf2f(unsigned h) { return __builtin_bit_cast(float, h << 16); }
__device__ __forceinline__ float bflo(unsigned w) { return __builtin_bit_cast(float, w << 16); }
__device__ __forceinline__ float bfhi(unsigned w) { return __builtin_bit_cast(float, w & 0xffff0000u); }
__device__ __forceinline__ unsigned pk4_fp8(float a, float b, float c, float d) { int w = 0; w = __builtin_amdgcn_cvt_pk_fp8_f32(a, b, w, false); w = __builtin_amdgcn_cvt_pk_fp8_f32(c, d, w, true); return (unsigned)w; }
constexpr float W_FP8_SCALE = 64.0f;
constexpr float HID_FP8_SCALE = 4.0f;
constexpr float H2_FP8_SCALE = 16.0f;
constexpr float MIX_FP8_SCALE = 16.0f;
constexpr float Y_FP8_SCALE = 16.0f;
__device__ __forceinline__ float wave_sum(float v) {
#pragma unroll
    for (int o = 1; o < 64; o <<= 1) v += __shfl_xor(v, o);
    return v;
}
__host__ __device__ __forceinline__ int qkv_phys32(int n0) { const int pn = n0 >> 8, w = n0 & 255, hh = w >> 6, bj = (w >> 5) & 1; return (pn << 8) + (bj << 7) + (hh << 5); }

template <bool FP8>
__device__ __forceinline__ void transpose_item(const float* W, int K, int N, void* WTv, bool perm, LAS float* scr, int item, int lane) {
    const int nblk = N / 32, kb = item / nblk, nb = item % nblk, k0 = 64 * kb, n0 = 32 * nb;
    const int lr = lane >> 3, lc = (lane & 7) * 4;
    f32x4 v[8];
#pragma unroll
    for (int i = 0; i < 8; ++i) v[i] = __builtin_nontemporal_load((const f32x4*)(W + (size_t)(k0 + 8 * i + lr) * N + n0 + lc));
#pragma unroll
    for (int i = 0; i < 8; ++i) *(LAS f32x4*)(scr + (8 * i + lr) * 36 + (lc ^ (i << 2))) = v[i];
    asm volatile("s_waitcnt lgkmcnt(0)" ::: "memory");
    const int c = lane & 7;
    const int ob = perm ? qkv_phys32(n0) : n0;
#pragma unroll
    for (int j = 0; j < 4; ++j) { const int n = (lane >> 3) + 8 * j; const LAS float* s = scr + (8 * c) * 36 + (n ^ (c << 2));
        if constexpr (FP8) { u32x2 o; o.x = pk4_fp8(s[0 * 36] * W_FP8_SCALE, s[1 * 36] * W_FP8_SCALE, s[2 * 36] * W_FP8_SCALE, s[3 * 36] * W_FP8_SCALE);
            o.y = pk4_fp8(s[4 * 36] * W_FP8_SCALE, s[5 * 36] * W_FP8_SCALE, s[6 * 36] * W_FP8_SCALE, s[7 * 36] * W_FP8_SCALE);
            __builtin_nontemporal_store(o, (u32x2*)((unsigned char*)WTv + (size_t)(ob + n) * K + k0 + 8 * c)); }
        else { u32x4 o; o.x = pk2(s[0 * 36], s[1 * 36]); o.y = pk2(s[2 * 36], s[3 * 36]); o.z = pk2(s[4 * 36], s[5 * 36]); o.w = pk2(s[6 * 36], s[7 * 36]);
            *(u32x4*)((bf16_t*)WTv + (size_t)(ob + n) * K + k0 + 8 * c) = o; } }
    asm volatile("s_waitcnt lgkmcnt(0)" ::: "memory");
}

constexpr int TI_IN = (DM / 64) * (D_IN / 32), TI_OUT = (DM / 64) * (DM / 32), TI_1 = (DM / 64) * (DU / 32), TI_2 = (DFF / 64) * (DM / 32);
constexpr int TI_ALL = TI_IN + TI_OUT + NEXP * (TI_1 + TI_2);
__device__ __forceinline__ void weight_items(const Params& P, int first, int last, int w, int nw, int lane, LAS float* scr) {
    unsigned char* ws = P.ws;
    bf16_t* WIN = (bf16_t*)(ws + WS_WIN); bf16_t* WOUT = (bf16_t*)(ws + WS_WOUT); bf16_t* W1T = (bf16_t*)(ws + WS_W1); bf16_t* W2T = (bf16_t*)(ws + WS_W2);
    for (int it = first + w; it < last; it += nw) {
        int r = it;
        if (r < TI_IN) { transpose_item<false>(P.w_in, DM, D_IN, WIN, true, scr, r, lane); continue; } r -= TI_IN;
        if (r < TI_OUT) { transpose_item<true>(P.w_out, DM, DM, WOUT, false, scr, r, lane); continue; } r -= TI_OUT;
        if (r < NEXP * TI_1) { const int e = r / TI_1; transpose_item<true>(P.w1 + (size_t)e * DM * DU, DM, DU, (unsigned char*)W1T + (size_t)e * DU * DM, false, scr, r % TI_1, lane); continue; } r -= NEXP * TI_1;
        { const int e = r / TI_2; transpose_item<true>(P.w2 + (size_t)e * DFF * DM, DFF, DM, (unsigned char*)W2T + (size_t)e * DM * DFF, false, scr, r % TI_2, lane); }
    }
}
__device__ __forceinline__ void p0_prologue(const Params& P, int gw, int ngw, int lane, LAS float* scr, int n_items) {
    unsigned char* ws = P.ws;
    weight_items(P, 0, n_items, gw, ngw, lane, scr);
    bf16_t* H1 = (bf16_t*)(ws + WS_H1); float* SR1 = (float*)(ws + WS_SR1);
    { f32x4 g[4];
#pragma unroll
      for (int j = 0; j < 4; ++j) g[j] = ((const f32x4*)P.g1 + lane)[64 * j];
      for (int t0 = 4 * gw; t0 < NTOK; t0 += 4 * ngw) {
        f32x4 v[4][4];
#pragma unroll
        for (int q = 0; q < 4; ++q) { const f32x4* xr = (const f32x4*)(P.x + (size_t)(t0 + q) * DM) + lane;
#pragma unroll
            for (int j = 0; j < 4; ++j) v[q][j] = __builtin_nontemporal_load(xr + 64 * j); }
#pragma unroll
        for (int q = 0; q < 4; ++q) { float ss = 0.f;
#pragma unroll
            for (int j = 0; j < 4; ++j) ss += (v[q][j].x * v[q][j].x + v[q][j].y * v[q][j].y) + (v[q][j].z * v[q][j].z + v[q][j].w * v[q][j].w);
            const float sd = sqrtf(wave_sum(ss) * (1.0f / DM) + EPS), rstd = 1.0f / sd;
            if (lane == 0) SR1[t0 + q] = sd;
            u32x2 w[4];
#pragma unroll
            for (int j = 0; j < 4; ++j) { w[j].x = pk2(v[q][j].x * rstd * g[j].x, v[q][j].y * rstd * g[j].y); w[j].y = pk2(v[q][j].z * rstd * g[j].z, v[q][j].w * rstd * g[j].w); }
            bf16_t* orow = H1 + (size_t)(t0 + q) * DM; const bool ev = !(lane & 1);
#pragma unroll
            for (int j = 0; j < 4; j += 2) { const unsigned sx = ev ? w[j + 1].x : w[j].x, sy = ev ? w[j + 1].y : w[j].y;
                const unsigned rx = (unsigned)__builtin_amdgcn_update_dpp(0, (int)sx, 0xB1, 0xF, 0xF, false), ry = (unsigned)__builtin_amdgcn_update_dpp(0, (int)sy, 0xB1, 0xF, 0xF, false);
                const u32x4 o4 = ev ? (u32x4){w[j].x, w[j].y, rx, ry} : (u32x4){rx, ry, w[j + 1].x, w[j + 1].y};
                *(u32x4*)(orow + 256 * (ev ? j : j + 1) + 4 * (lane & ~1)) = o4; } }
      } }
    { bf16_t* WRH = (bf16_t*)(ws + WS_WRH); bf16_t* WRL = (bf16_t*)(ws + WS_WRL);
      for (int idx = gw * 64 + lane; idx < NEXP * DM; idx += ngw * 64) { const int e = idx >> 10, k = idx & 1023;
          const float w = P.w_router[k * NEXP + e] * P.g2[k];   const unsigned h = f2bf(w); WRH[idx] = (bf16_t)h; WRL[idx] = (bf16_t)f2bf(w - bf2f(h)); } }
    _Float16* RC = (_Float16*)(ws + WS_ROPE); _Float16* RS = RC + (size_t)NTOK * 32;
    for (int idx = gw * 64 + lane; idx < NTOK * 32; idx += ngw * 64) {
        const int t = idx >> 5, i = idx & 31;
        const float inv = (float)exp2(-(double)i * (13.287712379549449 / 32.0));
        const float ang = (float)P.pos[t] * inv;
        const double a = (double)ang * 0.15915494309189535;
        const float fr = (float)(a - rint(a));
        RC[idx] = (_Float16)__builtin_amdgcn_cosf(fr); RS[idx] = (_Float16)__builtin_amdgcn_sinf(fr);
    }
}

namespace att {
typedef float f32x16 __attribute__((ext_vector_type(16)));
typedef short s16x4 __attribute__((ext_vector_type(4)));
constexpr int OOFF = 98304;
constexpr int KOFF = 0, VOFF = 49152;
constexpr float THR = 8.0f;
__device__ __forceinline__ int crow(int r, int hi) { return (r & 3) + 8 * (r >> 2) + 4 * hi; }
__device__ __forceinline__ s16x4 vtr(const LAS unsigned char* p) { return __builtin_bit_cast(s16x4, __builtin_amdgcn_ds_read_tr16_b64_v4i16((LAS s16x4*)p)); }
__device__ __forceinline__ void xswap(float v, float& a, float& b) { const unsigned u = __builtin_bit_cast(unsigned, v); auto rr = __builtin_amdgcn_permlane32_swap(u, u, false, false); const unsigned r0 = rr[0], r1 = rr[1]; a = __builtin_bit_cast(float, r0); b = __builtin_bit_cast(float, r1); }
__device__ __forceinline__ float xmax(float v) { float a, b; xswap(v, a, b); return fmaxf(a, b); }
__device__ __forceinline__ float xsum(float v) { float a, b; xswap(v, a, b); return a + b; }
typedef float af32x2 __attribute__((ext_vector_type(2)));
typedef __bf16 abf16x2 __attribute__((ext_vector_type(2)));
__device__ __forceinline__ unsigned cvtpk(float lo, float hi) { const af32x2 v = {lo, hi}; return __builtin_bit_cast(unsigned, __builtin_convertvector(v, abf16x2)); }

struct UnitInfo { int kind, h, r, nb, dm; size_t tok0; const bf16_t* qb; const bf16_t* kb; const bf16_t* vb; };
__device__ __forceinline__ UnitInfo decode(const Params& P, int unit) {
    UnitInfo u; const bf16_t* QKV = (const bf16_t*)(P.ws + WS_QKV);
    const int kind = unit >> 10, within = unit & 1023, b = within >> 7, h = (within >> 4) & 7, sub = within & 15;
    int r, c, nb, hq, hk, hv;
    if (kind == 0) { r = 1; c = 0; nb = sub; } else if (kind == 1) { r = 4; c = sub >> 2; nb = sub & 3; } else if (kind == 2) { r = 16; c = sub; nb = 0; } else { r = 1; c = 0; nb = sub; }
    if (kind < 3) { hq = h; hk = 8 + h; hv = 16 + h; u.dm = 0; } else { hq = 24 + h; hk = 32 + (h >> 2); hv = 34 + (h >> 2); u.dm = 1; }
    u.kind = kind; u.h = h; u.r = r; u.nb = nb; u.tok0 = (size_t)b * SEQ + c;
    u.qb = QKV + ((size_t)hq * NTOK + u.tok0) * 64; u.kb = QKV + ((size_t)hk * NTOK + u.tok0) * 64; u.vb = QKV + ((size_t)hv * NTOK + u.tok0) * 64;
    return u;
}
__device__ __forceinline__ void unit_loads(const UnitInfo& u, int tid, int lane, int wave, u32x4 (&kv)[6], u32x4 (&vv)[6], bf16x8 (&q)[4]) {
    const int c8 = tid & 7, j0 = tid >> 3, kbase = 256 * u.nb - 128;
#pragma unroll
    for (int i = 0; i < 6; ++i) { if (u.nb > 0 || i >= 2) { const long l = kbase + j0 + 64 * i; kv[i] = *(const u32x4*)(u.kb + l * u.r * 64 + c8 * 8); vv[i] = *(const u32x4*)(u.vb + l * u.r * 64 + c8 * 8); } }
    const bf16_t* qp = u.qb + (size_t)(256 * u.nb + 32 * wave + (lane & 31)) * u.r * 64 + 8 * (lane >> 5);
#pragma unroll
    for (int d0 = 0; d0 < 4; ++d0) q[d0] = *(const bf16x8*)(qp + 16 * d0);
}
__device__ __forceinline__ void unit_fill(LAS unsigned char* lds, int nb, int tid, const u32x4 (&kv)[6], const u32x4 (&vv)[6]) {
    const int c8 = tid & 7, j0 = tid >> 3, key = j0 & 31;
    LAS unsigned char* kd = lds + KOFF + (j0 >> 5) * 4096 + key * 128 + ((c8 ^ ((key >> 1) & 7)) << 4);
    LAS unsigned char* vd = lds + VOFF + (c8 >> 2) * 4096 + j0 * 64 + (c8 & 3) * 16;
#pragma unroll
    for (int i = 0; i < 6; ++i) { if (nb > 0 || i >= 2) { *(LAS u32x4*)(kd + i * 8192) = kv[i]; *(LAS u32x4*)(vd + i * 8192) = vv[i]; } }
}
__device__ __forceinline__ void unit_compute(const Params& P, LAS unsigned char* lds, const UnitInfo& u, const bf16x8 (&qr)[4], int lane, int wave) {
    const int r32 = lane & 31, hi = lane >> 5, nb = u.nb;
    float mref = 0.f, l = 0.f; f32x16 o[2];
    bf16x8 kone, qneg; { const u32x4 kb1 = {hi ? 0u : 0x3F80u, 0u, 0u, 0u}, z = {0u, 0u, 0u, 0u}; kone = __builtin_bit_cast(bf16x8, kb1); qneg = __builtin_bit_cast(bf16x8, z); }
#pragma unroll
    for (int x = 0; x < 16; ++x) { o[0][x] = 0.f; o[1][x] = 0.f; }
    const int vlane = ((lane >> 4) & 1) * 32 + (lane & 3) * 8 + (4 * hi + ((lane & 15) >> 2)) * 64;
#pragma unroll
    for (int jt = 4; jt >= 0; --jt) {
        const int kt = wave + jt;
        if (nb == 0 && kt < 4) break;
        const LAS unsigned char* kb = lds + KOFF + kt * 4096 + r32 * 128;
        f32x16 p;
#pragma unroll
        for (int x = 0; x < 16; ++x) p[x] = 0.f;
        if (jt != 4) p = __builtin_amdgcn_mfma_f32_32x32x16_bf16(kone, qneg, p, 0, 0, 0);
#pragma unroll
        for (int d0 = 0; d0 < 4; ++d0) { const bf16x8 kf = *(const LAS bf16x8*)(kb + (((2 * d0 + hi) ^ ((r32 >> 1) & 7)) << 4)); p = __builtin_amdgcn_mfma_f32_32x32x16_bf16(kf, qr[d0], p, 0, 0, 0); }
        if (jt == 4) {
#pragma unroll
            for (int x = 0; x < 16; ++x) if (crow(x, hi) > r32) p[x] = -INFINITY;
        }
        if (jt == 0) {
#pragma unroll
            for (int x = 0; x < 16; ++x) if (crow(x, hi) < r32 + u.dm) p[x] = -INFINITY;
        }
        if (jt == 4) {
            float tm = fmaxf(fmaxf(p[0], p[1]), p[2]);
#pragma unroll
            for (int x = 3; x < 15; x += 2) tm = fmaxf(fmaxf(tm, p[x]), p[x + 1]);
            { const unsigned rb = f2bf(xmax(fmaxf(tm, p[15]))); mref = bf2f(rb);
              const unsigned nb16 = hi ? 0u : (rb ^ 0x8000u); const u32x4 qb = {nb16, 0u, 0u, 0u}; qneg = __builtin_bit_cast(bf16x8, qb); }
#pragma unroll
            for (int x = 0; x < 16; ++x) p[x] = __builtin_amdgcn_exp2f(p[x] - mref);
        } else {
#pragma unroll
            for (int x = 0; x < 16; ++x) p[x] = __builtin_amdgcn_exp2f(p[x]);
        }
        float ls = 0.f;
#pragma unroll
        for (int x = 0; x < 16; ++x) ls += p[x];
        l += ls;
        u32x4 pw[2];
#pragma unroll
        for (int s2 = 0; s2 < 2; ++s2) { pw[s2].x = cvtpk(p[8 * s2 + 0], p[8 * s2 + 1]); pw[s2].y = cvtpk(p[8 * s2 + 2], p[8 * s2 + 3]); pw[s2].z = cvtpk(p[8 * s2 + 4], p[8 * s2 + 5]); pw[s2].w = cvtpk(p[8 * s2 + 6], p[8 * s2 + 7]); }
        const LAS unsigned char* vb = lds + VOFF + (kt >> 1) * 8192 + (kt & 1) * 2048 + vlane;
#pragma unroll
        for (int d0 = 0; d0 < 2; ++d0)
#pragma unroll
            for (int s2 = 0; s2 < 2; ++s2) { const s16x4 lo = vtr(vb + d0 * 4096 + s2 * 1024), hh = vtr(vb + d0 * 4096 + s2 * 1024 + 512);
                const bf16x8 vf = (bf16x8){lo[0], lo[1], lo[2], lo[3], hh[0], hh[1], hh[2], hh[3]};
                o[d0] = __builtin_amdgcn_mfma_f32_32x32x16_bf16(vf, __builtin_bit_cast(bf16x8, pw[s2]), o[d0], 0, 0, 0); }
    }
    l = xsum(l);
    const size_t t = u.tok0 + (size_t)(256 * nb + 32 * wave + r32) * u.r;
    float inv; bf16_t* dst; size_t pitch;
    if (u.kind < 3) { inv = 1.0f / l; dst = (bf16_t*)(P.ws + WS_PART) + ((size_t)u.kind * NTOK + u.tok0 + (size_t)(256 * nb + 32 * wave) * u.r) * 512 + u.h * 64;
        if (hi == 0) ((float*)(P.ws + WS_LSE))[((size_t)u.kind * 8 + u.h) * NTOK + t] = mref + __builtin_amdgcn_logf(l); }
    else { inv = 1.0f / (l + __builtin_amdgcn_exp2f(P.sinks[u.h] * LOG2E - mref)); dst = (bf16_t*)(P.ws + WS_OSWA) + (u.tok0 + (size_t)(256 * nb + 32 * wave) * u.r) * 512 + u.h * 64; }
    pitch = (size_t)u.r * 512;
    LAS unsigned char* stg = lds + OOFF + wave * 4096;
#pragma unroll
    for (int d0 = 0; d0 < 2; ++d0)
#pragma unroll
        for (int g = 0; g < 4; ++g) { u32x2 w; w.x = cvtpk(o[d0][4 * g] * inv, o[d0][4 * g + 1] * inv); w.y = cvtpk(o[d0][4 * g + 2] * inv, o[d0][4 * g + 3] * inv);
            *(LAS u32x2*)(stg + r32 * 128 + (((4 * d0 + g) ^ (r32 & 7)) << 4) + 8 * hi) = w; }
#pragma unroll
    for (int i = 0; i < 4; ++i) { const int row = 8 * i + (lane >> 3), ch = lane & 7;
        const u32x4 v = *(const LAS u32x4*)(stg + row * 128 + ((ch ^ (row & 7)) << 4));
        *(u32x4*)(dst + (size_t)row * pitch + 8 * ch) = v; }
}
__device__ __forceinline__ int unit_of(int it, int wg, int G) {
    if (G != 256) return it * G + wg;
    const int x = wg & 7, y = wg >> 3;
    const int gl = 2 * it + (y >> 4), sub = y & 15;
    int kind, b, h;
    if (gl < 24) { kind = gl % 3; b = gl / 3; h = x; } else {
    const int q = gl - 24; kind = 3; b = 4 * (q >> 2 & 1) + (x >> 1); h = 4 * (x & 1) + (q & 3); }
    return (kind << 10) | (b << 7) | (h << 4) | sub;
}
__device__ __forceinline__ void attn_phase(const Params& P, LAS unsigned char* lds, int tid, int lane, int wave) {
    const int G = gridDim.x, nit = (4096 + G - 1) / G; int it = 0;
    int unit = unit_of(0, blockIdx.x, G); if (unit >= 4096) return;
    UnitInfo cur = decode(P, unit);
    u32x4 kv[6], vv[6]; bf16x8 qn[4];
    unit_loads(cur, tid, lane, wave, kv, vv, qn);
    for (;;) {
        unit_fill(lds, cur.nb, tid, kv, vv);
        bf16x8 qr[4];
#pragma unroll
        for (int d0 = 0; d0 < 4; ++d0) qr[d0] = qn[d0];
        __syncthreads();
        const int nunit = (it + 1 < nit) ? unit_of(it + 1, blockIdx.x, G) : 4096; const bool has_next = nunit < 4096;
        UnitInfo nxt = cur;
        if (has_next) { nxt = decode(P, nunit); unit_loads(nxt, tid, lane, wave, kv, vv, qn); }
        unit_compute(P, lds, cur, qr, lane, wave);
        __syncthreads();
        if (!has_next) break;
        cur = nxt; unit = nunit; ++it;
    }
}
}

__device__ __forceinline__ void p2b_merge(const Params& P, int gw, int ngw, int lane) {
    unsigned char* ws = P.ws;
    const bf16_t* PART = (const bf16_t*)(ws + WS_PART); const bf16_t* OSWA = (const bf16_t*)(ws + WS_OSWA); const float* LSE = (const float*)(ws + WS_LSE);
    unsigned char* MIXED = ws + WS_MIXED;
    const f32x4 gda = *(const f32x4*)(P.gn_dil + lane * 8), gdb = *(const f32x4*)(P.gn_dil + lane * 8 + 4), gsa = *(const f32x4*)(P.gn_swa + lane * 8), gsb = *(const f32x4*)(P.gn_swa + lane * 8 + 4);
    const int h = lane >> 3;
    for (int t0 = 4 * gw; t0 < NTOK; t0 += 4 * ngw) {
        float ls[4][3]; u32x4 pv[4][3], sv[4];
#pragma unroll
        for (int c = 0; c < 3; ++c) { const f32x4 l4 = *(const f32x4*)(LSE + ((size_t)c * 8 + h) * NTOK + t0);
            ls[0][c] = l4[0]; ls[1][c] = l4[1]; ls[2][c] = l4[2]; ls[3][c] = l4[3]; }
#pragma unroll
        for (int q = 0; q < 4; ++q) { const int t = t0 + q;
#pragma unroll
            for (int c = 0; c < 3; ++c) pv[q][c] = *(const u32x4*)(PART + ((size_t)c * NTOK + t) * 512 + lane * 8);
            sv[q] = *(const u32x4*)(OSWA + (size_t)t * 512 + lane * 8); }
#pragma unroll
        for (int q = 0; q < 4; ++q) { const int t = t0 + q;
            const float mx = fmaxf(fmaxf(ls[q][0], ls[q][1]), ls[q][2]);
            float wsum = 0.f, w[3];
#pragma unroll
            for (int c = 0; c < 3; ++c) { w[c] = exp2f(ls[q][c] - mx); wsum += w[c]; }
            const float winv = 1.0f / wsum;
            float o[8];
#pragma unroll
            for (int i = 0; i < 8; ++i) o[i] = 0.f;
#pragma unroll
            for (int c = 0; c < 3; ++c) { const u32x4 v = pv[q][c]; const float wc = w[c] * winv;
                o[0] += wc * bflo(v.x); o[1] += wc * bfhi(v.x); o[2] += wc * bflo(v.y); o[3] += wc * bfhi(v.y);
                o[4] += wc * bflo(v.z); o[5] += wc * bfhi(v.z); o[6] += wc * bflo(v.w); o[7] += wc * bfhi(v.w); }
            float ss = 0.f;
#pragma unroll
            for (int i = 0; i < 8; ++i) ss += o[i] * o[i];
            float rstd = MIX_FP8_SCALE / sqrtf(wave_sum(ss) * (1.0f / 512.0f) + EPS);
            u32x2 wd; wd.x = pk4_fp8(o[0] * rstd * gda.x, o[1] * rstd * gda.y, o[2] * rstd * gda.z, o[3] * rstd * gda.w);
            wd.y = pk4_fp8(o[4] * rstd * gdb.x, o[5] * rstd * gdb.y, o[6] * rstd * gdb.z, o[7] * rstd * gdb.w);
            { const u32x4 v = sv[q];
              o[0] = bflo(v.x); o[1] = bfhi(v.x); o[2] = bflo(v.y); o[3] = bfhi(v.y); o[4] = bflo(v.z); o[5] = bfhi(v.z); o[6] = bflo(v.w); o[7] = bfhi(v.w); }
            ss = 0.f;
#pragma unroll
            for (int i = 0; i < 8; ++i) ss += o[i] * o[i];
            rstd = MIX_FP8_SCALE / sqrtf(wave_sum(ss) * (1.0f / 512.0f) + EPS);
            u32x2 wsw; wsw.x = pk4_fp8(o[0] * rstd * gsa.x, o[1] * rstd * gsa.y, o[2] * rstd * gsa.z, o[3] * rstd * gsa.w);
            wsw.y = pk4_fp8(o[4] * rstd * gsb.x, o[5] * rstd * gsb.y, o[6] * rstd * gsb.z, o[7] * rstd * gsb.w);
            { const bool ev = !(lane & 1); const unsigned sx = ev ? wsw.x : wd.x, sy = ev ? wsw.y : wd.y;
              const unsigned rx = (unsigned)__builtin_amdgcn_update_dpp(0, (int)sx, 0xB1, 0xF, 0xF, false), ry = (unsigned)__builtin_amdgcn_update_dpp(0, (int)sy, 0xB1, 0xF, 0xF, false);
              const u32x4 o4 = ev ? (u32x4){wd.x, wd.y, rx, ry} : (u32x4){rx, ry, wsw.x, wsw.y};
              *(u32x4*)(MIXED + (size_t)t * DM + (ev ? 0 : 512) + (lane & ~1) * 8) = o4; }
        }
    }
}

namespace route {
constexpr int NWAVES_R = 8;
constexpr int R_W = 0;
constexpr int R_LCNT = 131072 + 1024;
constexpr int R_REC = R_LCNT + 256;
constexpr int R_G2 = 131072 + 10240;
constexpr int XPRE = 32;
__device__ __forceinline__ void merge4(float (&v)[4], int (&e)[4], const float (&pv)[4], const int (&pe)[4]) {
    float cv[8]; int ce[8];
#pragma unroll
    for (int k = 0; k < 4; ++k) { cv[k] = v[k]; ce[k] = e[k]; cv[4 + k] = pv[k]; ce[4 + k] = pe[k]; }
#pragma unroll
    for (int k = 0; k < 4; ++k) { float best = -INFINITY; int bi = 0, be = 0;
#pragma unroll
        for (int x = 0; x < 8; ++x) { const bool better = (cv[x] > best) || (cv[x] == best && ce[x] < be); if (better) { best = cv[x]; bi = x; be = ce[x]; } }
        v[k] = best; e[k] = be;
#pragma unroll
        for (int x = 0; x < 8; ++x) cv[x] = (x == bi) ? -INFINITY : cv[x]; }
}
typedef float rf32x2 __attribute__((ext_vector_type(2)));
typedef __bf16 rbf16x2 __attribute__((ext_vector_type(2)));
__device__ __forceinline__ unsigned cvtpk(float lo, float hi) { const rf32x2 v = {lo, hi}; return __builtin_bit_cast(unsigned, __builtin_convertvector(v, rbf16x2)); }
__device__ __forceinline__ void route_block(const Params& P, LAS unsigned char* lds, int tb, int tid, int lane, int wave, bool stage) {
    unsigned char* ws = P.ws;
    bf16_t* H2 = (bf16_t*)(ws + WS_H2);
    const int tk = lane & 15, fq = lane >> 4;
    const int t = tb * 128 + wave * 16 + tk;
    LAS unsigned* lcnt = (LAS unsigned*)(lds + R_LCNT);
    const int ch = 2 * (fq & 1) + (fq >> 1);
    const bf16_t* xp = (const bf16_t*)(ws + WS_X1B) + (size_t)t * DM + 8 * ch;
    if (stage) {
        const u32x4* src = (const u32x4*)(P.ws + WS_WRH);
#pragma unroll 4
        for (int i = tid; i < 8192; i += NWAVES_R * 64) { const int half = i >> 12, e = (i >> 7) & 31, ch = i & 127;
            *(LAS u32x4*)(lds + R_W + half * 65536 + e * 2048 + ((ch ^ (e & 15)) << 4)) = src[i]; }
        if (tid < 256) *(LAS f32x4*)(lds + R_G2 + tid * 16) = *(const f32x4*)(P.g2 + tid * 4) * H2_FP8_SCALE;
    }
    u32x4 xwv[32];
#pragma unroll
    for (int ks = 0; ks < XPRE; ++ks) xwv[ks] = *(const u32x4*)(xp + 32 * ks);
    if (tid < 64) lcnt[tid] = 0u;
    asm volatile("s_waitcnt vmcnt(0) lgkmcnt(0)" ::: "memory");
    __builtin_amdgcn_s_barrier();
    const LAS float* gp = (const LAS float*)(lds + R_G2) + 8 * ch;
    const LAS unsigned char* wrow = lds + R_W + tk * 2048;
    unsigned char* hp = (unsigned char*)H2 + (size_t)t * DM + 32 * (fq >> 1) + 16 * (fq & 1);
    unsigned char* hp1 = tk < 8 ? hp : hp - 8 * DM + 64;
    unsigned char* hp2 = tk < 8 ? hp + 8 * DM : hp + 64;
    u32x2 hprev = {0u, 0u}; u32x4 hA = {0u, 0u, 0u, 0u};
    f32x4 d0 = {0.f, 0.f, 0.f, 0.f}, d1 = {0.f, 0.f, 0.f, 0.f};
    float ss = 0.f;
#pragma unroll
    for (int ks = 0; ks < 32; ++ks) {
        if (ks == 32 - XPRE) {
#pragma unroll
            for (int k2 = XPRE; k2 < 32; ++k2) xwv[k2] = *(const u32x4*)(xp + 32 * k2); }
        const u32x4 xw = xwv[ks]; const f32x4 xa = {bflo(xw.x), bfhi(xw.x), bflo(xw.y), bfhi(xw.y)}, xb = {bflo(xw.z), bfhi(xw.z), bflo(xw.w), bfhi(xw.w)}, ga = *(const LAS f32x4*)(gp + 32 * ks), gb = *(const LAS f32x4*)(gp + 32 * ks + 4);
        const int wo = ((4 * ks + ch) ^ tk) << 4;
        const bf16x8 ah0 = *(const LAS bf16x8*)(wrow + wo), al0 = *(const LAS bf16x8*)(wrow + 65536 + wo), ah1 = *(const LAS bf16x8*)(wrow + 32768 + wo), al1 = *(const LAS bf16x8*)(wrow + 98304 + wo);
        ss += (xa.x * xa.x + xa.y * xa.y) + (xa.z * xa.z + xa.w * xa.w) + (xb.x * xb.x + xb.y * xb.y) + (xb.z * xb.z + xb.w * xb.w);
        const f32x4 ha = xa * ga, hb = xb * gb;
        { u32x2 h8; h8.x = pk4_fp8(ha[0], ha[1], ha[2], ha[3]); h8.y = pk4_fp8(hb[0], hb[1], hb[2], hb[3]);
          if (ks & 1) { const auto r0 = __builtin_amdgcn_permlane32_swap(hprev.x, h8.x, false, false); const unsigned a0 = r0[0], b0 = r0[1];
                        const auto r1 = __builtin_amdgcn_permlane32_swap(hprev.y, h8.y, false, false); const unsigned a1 = r1[0], b1 = r1[1];
                        const u32x4 pc = {a0, a1, b0, b1};
                        if (ks & 2) {
                            u32x4 s1, s2;
                            s1.x = (unsigned)__builtin_amdgcn_update_dpp((int)hA.x, (int)pc.x, 0x128, 0xF, 0xC, false); s2.x = (unsigned)__builtin_amdgcn_update_dpp((int)pc.x, (int)hA.x, 0x128, 0xF, 0x3, false);
                            s1.y = (unsigned)__builtin_amdgcn_update_dpp((int)hA.y, (int)pc.y, 0x128, 0xF, 0xC, false); s2.y = (unsigned)__builtin_amdgcn_update_dpp((int)pc.y, (int)hA.y, 0x128, 0xF, 0x3, false);
                            s1.z = (unsigned)__builtin_amdgcn_update_dpp((int)hA.z, (int)pc.z, 0x128, 0xF, 0xC, false); s2.z = (unsigned)__builtin_amdgcn_update_dpp((int)pc.z, (int)hA.z, 0x128, 0xF, 0x3, false);
                            s1.w = (unsigned)__builtin_amdgcn_update_dpp((int)hA.w, (int)pc.w, 0x128, 0xF, 0xC, false); s2.w = (unsigned)__builtin_amdgcn_update_dpp((int)pc.w, (int)hA.w, 0x128, 0xF, 0x3, false);
                            *(u32x4*)(hp1 + 128 * (ks >> 2)) = s1; *(u32x4*)(hp2 + 128 * (ks >> 2)) = s2;
                        } else hA = pc; }
          else hprev = h8; }
        const bf16x8 xv = __builtin_bit_cast(bf16x8, xw);
        d0 = __builtin_amdgcn_mfma_f32_16x16x32_bf16(ah0, xv, d0, 0, 0, 0); d1 = __builtin_amdgcn_mfma_f32_16x16x32_bf16(ah1, xv, d1, 0, 0, 0);
        d0 = __builtin_amdgcn_mfma_f32_16x16x32_bf16(al0, xv, d0, 0, 0, 0); d1 = __builtin_amdgcn_mfma_f32_16x16x32_bf16(al1, xv, d1, 0, 0, 0);
    }
    ss += __shfl_xor(ss, 16); ss += __shfl_xor(ss, 32);
    const float rstd = 1.0f / sqrtf(ss * (1.0f / DM) + EPS);
    float v[8]; int ve[8];
#pragma unroll
    for (int i = 0; i < 4; ++i) { ve[i] = 4 * fq + i; ve[4 + i] = 16 + 4 * fq + i; v[i] = d0[i] * rstd + P.b_router[ve[i]]; v[4 + i] = d1[i] * rstd + P.b_router[ve[4 + i]]; }
    float tv[4]; int te[4];
#pragma unroll
    for (int k = 0; k < 4; ++k) { float best = -INFINITY; int bi = 0;
#pragma unroll
        for (int x = 0; x < 8; ++x) if (v[x] > best) { best = v[x]; bi = x; }
        tv[k] = best; te[k] = (bi < 4) ? (4 * fq + bi) : (12 + 4 * fq + bi);
#pragma unroll
        for (int x = 0; x < 8; ++x) v[x] = (x == bi) ? -INFINITY : v[x]; }
#pragma unroll
    for (int rnd = 0; rnd < 2; ++rnd) { float pv[4]; int pe[4];
#pragma unroll
        for (int k = 0; k < 4; ++k) { pv[k] = __shfl_xor(tv[k], 16 << rnd); pe[k] = __shfl_xor(te[k], 16 << rnd); }
        merge4(tv, te, pv, pe); }
    float gate[4], sum = 0.f;
#pragma unroll
    for (int k = 0; k < 4; ++k) { gate[k] = __expf(tv[k] - tv[0]); sum += gate[k]; }
    const float rs = 1.0f / sum;
    if (fq == 0) {
#pragma unroll
        for (int k = 0; k < 4; ++k) { const unsigned rank = __hip_atomic_fetch_add(&lcnt[te[k]], 1u, __ATOMIC_RELAXED, __HIP_MEMORY_SCOPE_WORKGROUP);
            *(LAS u32x4*)(lds + R_REC + ((wave * 16 + tk) * 4 + k) * 16) = (u32x4){(unsigned)te[k], rank, __builtin_bit_cast(unsigned, gate[k] * rs), __builtin_bit_cast(unsigned, rstd)}; } }
    __syncthreads();
    if (tid < 32) { unsigned* cnt = (unsigned*)(ws + WS_CTL) + CW_CNT; const unsigned c = lcnt[tid]; lcnt[32 + tid] = c ? atomicAdd(cnt + tid, c) : 0u; }
    __syncthreads();
    { int* TOKL = (int*)(ws + WS_TOKL); int* ASSIGN = (int*)(ws + WS_ASSIGN); float* GATE = (float*)(ws + WS_GATE); float* RSL = (float*)(ws + WS_RSL);
      const u32x4 rec = *(const LAS u32x4*)(lds + R_REC + tid * 16);
      const int tt = tb * 128 + (tid >> 2); const unsigned e = rec.x, pos = lcnt[32 + e] + rec.y;
      const unsigned gbits = rec.z, rbits = rec.w;
      TOKL[e * NTOK + pos] = tt; RSL[e * NTOK + pos] = __builtin_bit_cast(float, rbits); ASSIGN[tt * 4 + (tid & 3)] = (int)((e << 16) | pos); GATE[tt * 4 + (tid & 3)] = __builtin_bit_cast(float, gbits); }
    __syncthreads();
}
__device__ __forceinline__ void route_phase(const Params& P, LAS unsigned char* lds, int tid, int lane, int wave) {
    if ((int)blockIdx.x >= NTOK / 128) return;
    for (int tb = blockIdx.x; tb < NTOK / 128; tb += gridDim.x) route_block(P, lds, tb, tid, lane, wave, tb == (int)blockIdx.x);
}
}

__device__ __forceinline__ void expert_tiles(const unsigned* cnt, int lane, int& my_cnt, int& my_tstart) {
    const int c = (int)__hip_atomic_load(cnt + (lane & 31), __ATOMIC_RELAXED, __HIP_MEMORY_SCOPE_AGENT);
    const int tl = (c + 255) >> 8; int inc = tl;
#pragma unroll
    for (int o = 1; o < 32; o <<= 1) { const int up = __shfl_up(inc, o, 32); if ((lane & 31) >= o) inc += up; }
    my_cnt = c; my_tstart = inc - tl;
}

__device__ __forceinline__ void p7_combine(const Params& P, LAS unsigned char* lds, int gw, int ngw, int lane, float* dstbase) {
    typedef float f32x2 __attribute__((ext_vector_type(2)));
    unsigned char* ws = P.ws;
    const unsigned char* Y = (const unsigned char*)(ws + WS_Y); const u32x4* ASSIGN = (const u32x4*)(ws + WS_ASSIGN); const f32x4* GATE = (const f32x4*)(ws + WS_GATE);
    const unsigned* cnt = (const unsigned*)(ws + WS_CTL) + CW_CNT;
    int mycnt, myts; expert_tiles(cnt, lane, mycnt, myts);
    f32x4 gf4[4];
#pragma unroll
    for (int j = 0; j < 4; ++j) gf4[j] = *((const f32x4*)P.gf + 64 * j + lane);
    LAS unsigned char* tsp = lds + (threadIdx.x >> 6) * 8192;
    int t0 = 2 * gw; if (t0 >= NTOK) return;
    u32x4 an[2]; f32x4 gn[2];
#pragma unroll
    for (int q = 0; q < 2; ++q) { an[q] = ASSIGN[t0 + q]; gn[q] = GATE[t0 + q]; }
    for (; t0 < NTOK; t0 += 2 * ngw) {
        u32x4 a[2]; f32x4 g[2];
#pragma unroll
        for (int q = 0; q < 2; ++q) { a[q] = an[q]; g[q] = gn[q]; }
        const int tn = (t0 + 2 * ngw < NTOK) ? t0 + 2 * ngw : t0;
#pragma unroll
        for (int q = 0; q < 2; ++q) { an[q] = ASSIGN[tn + q]; gn[q] = GATE[tn + q]; }
        u32x4 yv[2][4], xa[2], xb[2];
#pragma unroll
        for (int q = 0; q < 2; ++q) { const u32x4* xr = (const u32x4*)((const bf16_t*)(ws + WS_X1B) + (size_t)(t0 + q) * DM) + 2 * lane; xa[q] = xr[0]; xb[q] = xr[1];
            const unsigned aw[4] = {a[q].x, a[q].y, a[q].z, a[q].w};
#pragma unroll
            for (int k = 0; k < 4; ++k) { const int e = (int)(aw[k] >> 16), pos = (int)(aw[k] & 0xffffu); const int ts = __shfl(myts, e); yv[q][k] = __builtin_nontemporal_load((const u32x4*)(Y + ((size_t)ts * 256 + pos) * DM) + lane); } }
#pragma unroll
        for (int q = 0; q < 2; ++q) {
            f32x4 v[4];
            v[0] = (f32x4){bflo(xa[q].x), bfhi(xa[q].x), bflo(xa[q].y), bfhi(xa[q].y)}; v[1] = (f32x4){bflo(xa[q].z), bfhi(xa[q].z), bflo(xa[q].w), bfhi(xa[q].w)};
            v[2] = (f32x4){bflo(xb[q].x), bfhi(xb[q].x), bflo(xb[q].y), bfhi(xb[q].y)}; v[3] = (f32x4){bflo(xb[q].z), bfhi(xb[q].z), bflo(xb[q].w), bfhi(xb[q].w)};
            const float gk[4] = {g[q].x * (1.0f / Y_FP8_SCALE), g[q].y * (1.0f / Y_FP8_SCALE), g[q].z * (1.0f / Y_FP8_SCALE), g[q].w * (1.0f / Y_FP8_SCALE)};
#pragma unroll
            for (int k = 0; k < 4; ++k) { const unsigned yw[4] = {yv[q][k].x, yv[q][k].y, yv[q][k].z, yv[q][k].w};
#pragma unroll
                for (int j = 0; j < 4; ++j) { const f32x2 lo = __builtin_amdgcn_cvt_pk_f32_fp8((int)yw[j], false), hi = __builtin_amdgcn_cvt_pk_f32_fp8((int)yw[j], true);
                    v[j].x += gk[k] * lo.x; v[j].y += gk[k] * lo.y; v[j].z += gk[k] * hi.x; v[j].w += gk[k] * hi.y; } }
            float ss = 0.f;
#pragma unroll
            for (int j = 0; j < 4; ++j) ss += (v[j].x * v[j].x + v[j].y * v[j].y) + (v[j].z * v[j].z + v[j].w * v[j].w);
            const float rstd = 1.0f / sqrtf(wave_sum(ss) * (1.0f / DM) + EPS);
            LAS unsigned char* tq = tsp + q * 4096;
#pragma unroll
            for (int j = 0; j < 4; ++j) *(LAS f32x4*)(tq + 64 * lane + 16 * (j ^ (lane & 3))) = v[j] * rstd;
            asm volatile("s_waitcnt lgkmcnt(0)" ::: "memory");
            f32x4* dr = (f32x4*)(dstbase + (size_t)(t0 + q) * DM) + lane;
#pragma unroll
            for (int j = 0; j < 4; ++j) { const int c = 256 * j + 4 * lane, sl = c >> 4, sj = (c >> 2) & 3;
                dr[64 * j] = *(const LAS f32x4*)(tq + 64 * sl + 16 * (sj ^ (sl & 3))) * gf4[j]; }
        }
    }
}

namespace pg8 {
constexpr int BM = 256, BK = 64, HALF = 128, HTB = HALF * BK * 2, STAGE_BYTES = 8 * HTB, NXCD = 8, WGM = 8;
constexpr int EPI_SLOT_OFF = 131072 + 10240 + 512;
__host__ __device__ __forceinline__ int lds_byte(int r, int c) { const int st = (r >> 4) * 2 + (c >> 5), rr = r & 15, cc = c & 31, ob = rr * 64 + cc * 2; return st * 1024 + (ob ^ (((ob >> 9) & 1) << 5)); }
__host__ __device__ __forceinline__ void stage_rc(int b, int& R, int& C) { const int st = b / 1024, sb = b % 1024, swz = sb ^ (((sb >> 9) & 1) << 5); R = (st >> 1) * 16 + swz / 64; C = (st & 1) * 32 + (swz % 64) / 2; }
__host__ __device__ __forceinline__ int perm32(int rho) { const int n = rho >> 4, i = rho & 15; return 8 * (i >> 2) + 4 * n + (i & 3); }
struct Unit { int pm, pn, e, rt; };

__device__ __forceinline__ bool tile_order(int i, int G, int c, int nM, int nN, int& pm, int& pn) {
    const int nwg = nM * nN; const long L = (long)i * G + c; if (L >= nwg) return false;
    int wgid = (int)L; { const int q = nwg / NXCD, r = nwg % NXCD, xcd = wgid % NXCD, off = wgid / NXCD; wgid = (xcd < r ? xcd * (q + 1) : r * (q + 1) + (xcd - r) * q) + off; }
    const int nig = WGM * nN, gid = wgid / nig, fm = gid * WGM, gsz = (nM - fm) < WGM ? (nM - fm) : WGM;
    pm = fm + ((wgid % nig) % gsz); pn = (wgid % nig) / gsz; return true;
}
struct DenseOrder {
    const char* A; const char* Bt; int nM, nN, G, c; size_t tstep;
    __device__ __forceinline__ void init(const void* A_, const void* Bt_, int M, int N, int KB, int G_, int c_) { A = (const char*)A_; Bt = (const char*)Bt_; nM = M / BM; nN = N / BM; G = G_; c = c_; tstep = (size_t)BM * KB; }
    __device__ __forceinline__ bool next(int i, Unit& u) const { u.e = 0; u.rt = 0; return tile_order(i, G, c, nM, nN, u.pm, u.pn); }
    __device__ __forceinline__ const char* a_base(const Unit& u) const { return A + (size_t)u.pm * tstep; }
    __device__ __forceinline__ const char* b_base(const Unit& u) const { return Bt + (size_t)u.pn * tstep; }
    __device__ __forceinline__ void a_rows(const Unit&, unsigned (&)[2][2]) const {}
    __device__ __forceinline__ void a_rows_stage(const Unit&, LAS unsigned char*, int, int) const {}
    __device__ __forceinline__ void a_rows_lds(const Unit&, const LAS unsigned char*, unsigned (&)[2][2]) const {}
};
struct GroupedOrder {
    const char* A; const char* Bt; const int* tokl; const LAS int* tab; int NT, nN, G, c, KA, KB; size_t bexp;
    __device__ __forceinline__ bool next(int i, Unit& u) const {
        if (!tile_order(i, G, c, NT, nN, u.pm, u.pn)) return false;
        const int ts = tab[threadIdx.x & 31];
        const unsigned long long bal = __ballot(ts <= u.pm);
        const int e = __builtin_popcount((unsigned)bal) - 1;
        u.e = __builtin_amdgcn_readfirstlane(e); u.rt = u.pm - __builtin_amdgcn_readfirstlane(tab[u.e]); return true;
    }
    __device__ __forceinline__ const char* a_base(const Unit& u) const { return tokl ? A : A + (size_t)u.pm * BM * KA; }
    __device__ __forceinline__ const char* b_base(const Unit& u) const { return Bt + (size_t)u.e * bexp + (size_t)u.pn * BM * KB; }
    __device__ __forceinline__ void a_rows(const Unit& u, unsigned (&gv)[2][2]) const {
        const int ce = __builtin_amdgcn_readfirstlane(tab[32 + u.e]);
#pragma unroll
        for (int h = 0; h < 2; ++h)
#pragma unroll
            for (int i = 0; i < 2; ++i) { int R, C; stage_rc((int)threadIdx.x * 16 + i * 8192, R, C);
                const int pos = u.rt * BM + h * HALF + R; const int tok = pos < ce ? tokl[u.e * NTOK + pos] : 0; gv[h][i] = (unsigned)tok * (unsigned)KA + (unsigned)(C * 2); }
    }
    __device__ __forceinline__ void a_rows_stage(const Unit& u, LAS unsigned char* slot, int wid, int lane) const {
        if (wid == 2) __builtin_amdgcn_global_load_lds((const unsigned*)(tokl + (size_t)u.e * NTOK + u.rt * BM + 4 * lane), (LAS unsigned*)slot, 16, 0, 0);
    }
    __device__ __forceinline__ void a_rows_lds(const Unit& u, const LAS unsigned char* slot, unsigned (&gv)[2][2]) const {
        const int ce = __builtin_amdgcn_readfirstlane(tab[32 + u.e]);
#pragma unroll
        for (int h = 0; h < 2; ++h)
#pragma unroll
            for (int i = 0; i < 2; ++i) { int R, C; stage_rc((int)threadIdx.x * 16 + i * 8192, R, C);
                const int pl = h * HALF + R; const int tv = ((const LAS int*)slot)[pl]; const int tok = (u.rt * BM + pl) < ce ? tv : 0; gv[h][i] = (unsigned)tok * (unsigned)KA + (unsigned)(C * 2); }
    }
};

__device__ __forceinline__ unsigned cvt_pk_bf16(float lo, float hi) { unsigned r; asm volatile("v_cvt_pk_bf16_f32 %0, %1, %2\n\ts_nop 1" : "=v"(r) : "v"(lo), "v"(hi)); return r; }

typedef int v8i32 __attribute__((ext_vector_type(8)));
typedef unsigned u32x8 __attribute__((ext_vector_type(8)));
template <bool GATHER, bool FP8, class Epi, class Sched, bool ALIGN_EPI>
__device__ __forceinline__ void gemm_phase(LAS unsigned char* lds, const int KB, const Sched& S, const Epi& E) {
    const int tid = threadIdx.x, wid = __builtin_amdgcn_readfirstlane(tid >> 6), lane = tid & 63, wr = wid >> 2, wc = wid & 3, fr = lane & 15, fq = lane >> 4;
    const int nt = KB / 128;
    unsigned voffA[2], voffB[2];
#pragma unroll
    for (int i = 0; i < 2; ++i) { int R, C; stage_rc(tid * 16 + i * 8192, R, C);
        const int Rb = (int)Epi::PERM == 4 ? (64 * (R >> 5) + perm32(R & 31)) : (int)Epi::PERM == 3 ? (64 * (R >> 5) + 16 * (2 * (((R & 15) >> 2) & 1) + ((R & 15) >> 3)) + 4 * ((R >> 4) & 1) + (((R & 1) << 1) | ((R >> 1) & 1))) : (int)Epi::PERM == 2 ? (64 * (R >> 5) + 16 * ((R & 15) >> 2) + 4 * ((R >> 4) & 1) + (R & 3)) : (int)Epi::PERM == 1 ? ((R & ~31) + perm32(R & 31)) : R;
        voffA[i] = (unsigned)(R * KB + C * 2); voffB[i] = (unsigned)(Rb * KB + C * 2); }
    const size_t kstep = (size_t)(BK * 2);
    const size_t hstep = (size_t)HALF * KB;
    const size_t hstepA = GATHER ? (size_t)0 : hstep;
    const size_t hstepB = (int)Epi::PERM == 4 ? (size_t)32 * KB : (int)Epi::PERM >= 2 ? (size_t)8 * KB : hstep;
    const unsigned ldsw = (unsigned)wid * 1024u;
    const int aoff = lds_byte(wr * 64 + fr, fq * 8), boff = lds_byte(wc * 32 + fr, fq * 8);
#define PG8_SA(b, h) (((b) * 2 + (h)) * HTB)
#define PG8_SB(b, h) ((4 + (b) * 2 + (h)) * HTB)
#define PG8_STAGE(bufoff, gbase, voff) do { _Pragma("unroll") for (int _i = 0; _i < 2; ++_i) \
        __builtin_amdgcn_global_load_lds((const unsigned*)((const char*)(gbase) + (voff)[_i]), (LAS unsigned*)(lds + (bufoff) + ldsw + _i * 8192), 16, 0, 0); } while (0)
#define PG8_STAGE_A(bufoff, gbase, h, gvsel) do { if constexpr (GATHER) { PG8_STAGE(bufoff, gbase, gvsel[h]); } else { PG8_STAGE(bufoff, gbase, voffA); } } while (0)
#define PG8_LD32(addr) (u32x8)__builtin_shufflevector(*(const LAS u32x4*)(addr), *(const LAS u32x4*)((addr) + 1024), 0, 1, 2, 3, 4, 5, 6, 7)
#define PG8_LDA(dst, b, h) do { if constexpr (FP8) { _Pragma("unroll") for (int m = 0; m < 4; ++m) dst##8[m] = PG8_LD32(lds + PG8_SA(b, h) + aoff + m * 2048); } \
    else { _Pragma("unroll") for (int m = 0; m < 4; ++m) _Pragma("unroll") for (int k = 0; k < 2; ++k) dst[m][k] = *(const LAS bf16x8*)(lds + PG8_SA(b, h) + aoff + m * 2048 + k * 1024); } } while (0)
#define PG8_LDB(dst, b, h) do { if constexpr (FP8) { _Pragma("unroll") for (int n = 0; n < 2; ++n) dst##8[n] = PG8_LD32(lds + PG8_SB(b, h) + boff + n * 2048); } \
    else { _Pragma("unroll") for (int n = 0; n < 2; ++n) _Pragma("unroll") for (int k = 0; k < 2; ++k) dst[n][k] = *(const LAS bf16x8*)(lds + PG8_SB(b, h) + boff + n * 2048 + k * 1024); } } while (0)
#define PG8_MMA(ai, bj, At, Bt) do { __builtin_amdgcn_s_setprio(1); if constexpr (FP8) { _Pragma("unroll") for (int m = 0; m < 4; ++m) _Pragma("unroll") for (int n = 0; n < 2; ++n) \
        asm volatile("v_mfma_f32_16x16x128_f8f6f4 %0, %1, %2, %0" : "+v"(acc[ai][bj][m][n]) : "v"(Bt##8[n]), "v"(At##8[m])); } \
    else { _Pragma("unroll") for (int m = 0; m < 4; ++m) _Pragma("unroll") for (int n = 0; n < 2; ++n) _Pragma("unroll") for (int k = 0; k < 2; ++k) \
        acc[ai][bj][m][n] = __builtin_amdgcn_mfma_f32_16x16x32_bf16(Bt[n][k], At[m][k], acc[ai][bj][m][n], 0, 0, 0); } __builtin_amdgcn_s_setprio(0); } while (0)
#define PG8_MMAZ(ai, bj, At, Bt, z) do { if constexpr (FP8) { if (z) { __builtin_amdgcn_s_setprio(1); _Pragma("unroll") for (int m = 0; m < 4; ++m) _Pragma("unroll") for (int n = 0; n < 2; ++n) \
        asm volatile("v_mfma_f32_16x16x128_f8f6f4 %0, %1, %2, 0" : "=&v"(acc[ai][bj][m][n]) : "v"(Bt##8[n]), "v"(At##8[m])); __builtin_amdgcn_s_setprio(0); } else PG8_MMA(ai, bj, At, Bt); } \
    else { if (z) { __builtin_amdgcn_s_setprio(1); _Pragma("unroll") for (int m = 0; m < 4; ++m) _Pragma("unroll") for (int n = 0; n < 2; ++n) { \
        acc[ai][bj][m][n] = __builtin_amdgcn_mfma_f32_16x16x32_bf16(Bt[n][0], At[m][0], (f32x4){0.f, 0.f, 0.f, 0.f}, 0, 0, 0); acc[ai][bj][m][n] = __builtin_amdgcn_mfma_f32_16x16x32_bf16(Bt[n][1], At[m][1], acc[ai][bj][m][n], 0, 0, 0); } \
        __builtin_amdgcn_s_setprio(0); } else PG8_MMA(ai, bj, At, Bt); } } while (0)
#define PG8_WAIT_V(n) asm volatile("s_waitcnt vmcnt(" #n ")" ::: "memory")
#define PG8_WAIT_L(n) asm volatile("s_waitcnt lgkmcnt(" #n ")" ::: "memory")
#define PG8_BAR __builtin_amdgcn_s_barrier()
#define PG8_SCHED __builtin_amdgcn_sched_barrier(0)
    Unit cur, nxt; int ui = 0;
    if (!S.next(0, cur)) return;
    f32x4 acc[2][2][4][2];
    bf16x8 At[4][2], B0[2][2], B1[2][2]; u32x8 At8[4], B08[2], B18[2];
    const char* cA = S.a_base(cur); const char* cB = S.b_base(cur);
    unsigned gvc[2][2] = {{0u, 0u}, {0u, 0u}};
    LAS unsigned char* tslot = lds + EPI_SLOT_OFF + 4096;
    if constexpr (GATHER) S.a_rows(cur, gvc);
    PG8_STAGE(PG8_SB(0, 0), cB, voffB); PG8_STAGE(PG8_SB(0, 1), cB + hstepB, voffB); PG8_STAGE_A(PG8_SA(0, 0), cA, 0, gvc); PG8_STAGE_A(PG8_SA(0, 1), cA + hstepA, 1, gvc);
    if (wr == 1) PG8_BAR;
    PG8_WAIT_V(2); PG8_BAR;
    PG8_STAGE(PG8_SB(1, 0), cB + kstep, voffB); PG8_STAGE_A(PG8_SA(1, 0), cA + kstep, 0, gvc); PG8_STAGE(PG8_SB(1, 1), cB + hstepB + kstep, voffB);
    PG8_WAIT_V(6); PG8_BAR;
    for (;;) {
        const bool has_next = S.next(ui + 1, nxt);
        const char* nA = has_next ? S.a_base(nxt) : cA; const char* nB = has_next ? S.b_base(nxt) : cB;
        if constexpr (GATHER) { if (has_next) S.a_rows_stage(nxt, tslot, wid, lane); }
        LAS unsigned char* eslot = lds + EPI_SLOT_OFF + (ui & 1) * 2048;
        E.stage(cur, eslot, wid, lane);
#pragma unroll 1
        for (int t = 0; t < nt; t += 2) {
            const bool last = (t == nt - 2), first = (t == 0);
            const char* a1 = cA + (size_t)(t + 1) * kstep;
            const char* a2 = last ? nA : cA + (size_t)(t + 2) * kstep; const char* b2 = last ? nB : cB + (size_t)(t + 2) * kstep;
            const char* a3 = a2 + kstep; const char* b3 = b2 + kstep;
            PG8_LDB(B0, 0, 0); PG8_LDB(B1, 0, 1); PG8_SCHED; PG8_LDA(At, 0, 0); PG8_STAGE_A(PG8_SA(1, 1), a1 + hstepA, 1, gvc);
            if constexpr (GATHER) { if (last && has_next) S.a_rows_lds(nxt, tslot, gvc); }
            PG8_WAIT_V(8); PG8_WAIT_L(0); PG8_BAR; PG8_MMAZ(0, 0, At, B0, first); PG8_MMAZ(0, 1, At, B1, first); PG8_BAR; PG8_SCHED;
            PG8_LDA(At, 0, 1); PG8_STAGE(PG8_SB(0, 0), b2, voffB); PG8_STAGE(PG8_SB(0, 1), b2 + hstepB, voffB); PG8_STAGE_A(PG8_SA(0, 0), a2, 0, gvc);
            PG8_WAIT_V(8); PG8_WAIT_L(0); PG8_BAR; PG8_MMAZ(1, 0, At, B0, first); PG8_MMAZ(1, 1, At, B1, first); PG8_BAR; PG8_SCHED;
            PG8_LDB(B0, 1, 0); PG8_LDB(B1, 1, 1); PG8_SCHED; PG8_LDA(At, 1, 0); PG8_STAGE_A(PG8_SA(0, 1), a2 + hstepA, 1, gvc);
            PG8_WAIT_V(8); PG8_WAIT_L(0); PG8_BAR; PG8_MMA(0, 0, At, B0); PG8_MMA(0, 1, At, B1); PG8_BAR; PG8_SCHED;
            PG8_LDA(At, 1, 1); PG8_STAGE(PG8_SB(1, 0), b3, voffB); PG8_STAGE(PG8_SB(1, 1), b3 + hstepB, voffB); PG8_STAGE_A(PG8_SA(1, 0), a3, 0, gvc);
            PG8_WAIT_V(8); PG8_WAIT_L(0); PG8_BAR; PG8_MMA(1, 0, At, B0); PG8_MMA(1, 1, At, B1); PG8_BAR; PG8_SCHED;
        }
        if constexpr (ALIGN_EPI) { if (wr == 0) PG8_BAR; }
        if constexpr (FP8) asm volatile("s_nop 15\n\ts_nop 15" ::: "memory");
        E(acc, cur, wr, wc, fr, fq, eslot);
        if (!has_next) break;
        cur = nxt; cA = nA; cB = nB; ++ui;
        if constexpr (ALIGN_EPI) { if (wr == 1) PG8_BAR; }
    }
    PG8_WAIT_V(0);
    if constexpr (!ALIGN_EPI) { if (wr == 0) PG8_BAR; }
    PG8_BAR;
#undef PG8_SA
#undef PG8_SB
#undef PG8_STAGE
#undef PG8_STAGE_A
#undef PG8_LDA
#undef PG8_LDB
#undef PG8_MMA
#undef PG8_MMAZ
#undef PG8_LD32
#undef PG8_WAIT_V
#undef PG8_WAIT_L
#undef PG8_BAR
#undef PG8_SCHED
}

typedef _Float16 h16x8 __attribute__((ext_vector_type(8)));
struct EpiQKV {
    static constexpr int PERM = 1;
    bf16_t* QKV; const float* bias; const _Float16* RC; const _Float16* RS;
    __device__ __forceinline__ void stage(const Unit& u, LAS unsigned char* slot, int wid, int lane) const {
        if (wid == 0) __builtin_amdgcn_global_load_lds((const unsigned*)(bias + u.pn * BM + 4 * lane), (LAS unsigned*)slot, 16, 0, 0);
    }
    __device__ __forceinline__ void operator()(const f32x4 (&acc)[2][2][4][2], const Unit& u, int wr, int wc, int fr, int fq, const LAS unsigned char* slot) const {
        const int hs = u.pn * 4 + wc; const bool rope = (hs < 16) || (hs >= 24 && hs < 34); const float sc = (hs < 8 || (hs >= 24 && hs < 32)) ? QSCALE : 1.0f;
        const LAS float* bsl = (const LAS float*)slot + wc * 64 + 8 * fq;
        auto put = [&](int t, const u32x4& w1, const u32x4& w2) {
            u32x4 dA, dB;
            dA.x = (unsigned)__builtin_amdgcn_update_dpp((int)w1.x, (int)w2.x, 0x128, 0xF, 0xC, false); dA.y = (unsigned)__builtin_amdgcn_update_dpp((int)w1.y, (int)w2.y, 0x128, 0xF, 0xC, false);
            dA.z = (unsigned)__builtin_amdgcn_update_dpp((int)w1.z, (int)w2.z, 0x128, 0xF, 0xC, false); dA.w = (unsigned)__builtin_amdgcn_update_dpp((int)w1.w, (int)w2.w, 0x128, 0xF, 0xC, false);
            dB.x = (unsigned)__builtin_amdgcn_update_dpp((int)w2.x, (int)w1.x, 0x128, 0xF, 0x3, false); dB.y = (unsigned)__builtin_amdgcn_update_dpp((int)w2.y, (int)w1.y, 0x128, 0xF, 0x3, false);
            dB.z = (unsigned)__builtin_amdgcn_update_dpp((int)w2.z, (int)w1.z, 0x128, 0xF, 0x3, false); dB.w = (unsigned)__builtin_amdgcn_update_dpp((int)w2.w, (int)w1.w, 0x128, 0xF, 0x3, false);
            bf16_t* dst = QKV + ((size_t)hs * NTOK + (t - fr + (fr & 7))) * 64 + (fr < 8 ? 0 : 32) + 8 * fq;
            *(u32x4*)dst = dA; *(u32x4*)(dst + 8 * 64) = dB; };
        if (rope) {
            h16x8 cs[2][4], sn[2][4];
#pragma unroll
            for (int ai = 0; ai < 2; ++ai)
#pragma unroll
                for (int m = 0; m < 4; ++m) { const size_t t = (size_t)(u.pm * BM + ai * HALF + wr * 64 + m * 16 + fr); cs[ai][m] = *(const h16x8*)(RC + t * 32 + 8 * fq); sn[ai][m] = *(const h16x8*)(RS + t * 32 + 8 * fq); }
            asm volatile("" ::: "memory");
#pragma unroll
            for (int ai = 0; ai < 2; ++ai)
#pragma unroll
                for (int m = 0; m < 4; ++m) { const int t = u.pm * BM + ai * HALF + wr * 64 + m * 16 + fr;
                    f32x4 o1[2], o2[2];
#pragma unroll
                    for (int n = 0; n < 2; ++n) { const f32x4 v1 = acc[ai][0][m][n] + *(const LAS f32x4*)(bsl + 4 * n), v2 = acc[ai][1][m][n] + *(const LAS f32x4*)(bsl + 32 + 4 * n);
                        const f32x4 c = (f32x4){(float)cs[ai][m][4 * n], (float)cs[ai][m][4 * n + 1], (float)cs[ai][m][4 * n + 2], (float)cs[ai][m][4 * n + 3]} * sc;
                        const f32x4 sv = (f32x4){(float)sn[ai][m][4 * n], (float)sn[ai][m][4 * n + 1], (float)sn[ai][m][4 * n + 2], (float)sn[ai][m][4 * n + 3]} * sc;
                        o1[n] = v1 * c - v2 * sv; o2[n] = v2 * c + v1 * sv; }
                    u32x4 w1, w2; w1.x = cvt_pk_bf16(o1[0][0], o1[0][1]); w1.y = cvt_pk_bf16(o1[0][2], o1[0][3]); w1.z = cvt_pk_bf16(o1[1][0], o1[1][1]); w1.w = cvt_pk_bf16(o1[1][2], o1[1][3]);
                    w2.x = cvt_pk_bf16(o2[0][0], o2[0][1]); w2.y = cvt_pk_bf16(o2[0][2], o2[0][3]); w2.z = cvt_pk_bf16(o2[1][0], o2[1][1]); w2.w = cvt_pk_bf16(o2[1][2], o2[1][3]);
                    put(t, w1, w2); }
        } else {
#pragma unroll
            for (int ai = 0; ai < 2; ++ai)
#pragma unroll
                for (int m = 0; m < 4; ++m) { const int t = u.pm * BM + ai * HALF + wr * 64 + m * 16 + fr;
                    f32x4 o1[2], o2[2];
#pragma unroll
                    for (int n = 0; n < 2; ++n) { o1[n] = acc[ai][0][m][n] + *(const LAS f32x4*)(bsl + 4 * n); o2[n] = acc[ai][1][m][n] + *(const LAS f32x4*)(bsl + 32 + 4 * n); }
                    u32x4 w1, w2; w1.x = cvt_pk_bf16(o1[0][0], o1[0][1]); w1.y = cvt_pk_bf16(o1[0][2], o1[0][3]); w1.z = cvt_pk_bf16(o1[1][0], o1[1][1]); w1.w = cvt_pk_bf16(o1[1][2], o1[1][3]);
                    w2.x = cvt_pk_bf16(o2[0][0], o2[0][1]); w2.y = cvt_pk_bf16(o2[0][2], o2[0][3]); w2.z = cvt_pk_bf16(o2[1][0], o2[1][1]); w2.w = cvt_pk_bf16(o2[1][2], o2[1][3]);
                    put(t, w1, w2); }
        }
    }
};
struct EpiOut {
    static constexpr int PERM = 4;
    const bf16_t* h1; const float* sr1; const float* g1; bf16_t* x1b; const float* bias; float oscale;
    __device__ __forceinline__ void stage(const Unit& u, LAS unsigned char* slot, int wid, int lane) const {
        if (wid == 0) __builtin_amdgcn_global_load_lds((const unsigned*)(sr1 + u.pm * BM + 4 * lane), (LAS unsigned*)slot, 16, 0, 0);
    }
    __device__ __forceinline__ void operator()(const f32x4 (&acc)[2][2][4][2], const Unit& u, int wr, int wc, int fr, int fq, const LAS unsigned char* slot) const {
        const int col0 = u.pn * BM + wc * 64 + 8 * fq;
        const LAS float* srp = (const LAS float*)slot + wr * 64 + fr;
        f32x4 bv[2][2], gi[2][2];
#pragma unroll
        for (int bj = 0; bj < 2; ++bj)
#pragma unroll
            for (int n = 0; n < 2; ++n) { bv[bj][n] = *(const f32x4*)(bias + col0 + bj * 32 + 4 * n); const f32x4 g = *(const f32x4*)(g1 + col0 + bj * 32 + 4 * n);
                gi[bj][n] = (f32x4){__builtin_amdgcn_rcpf(g[0]), __builtin_amdgcn_rcpf(g[1]), __builtin_amdgcn_rcpf(g[2]), __builtin_amdgcn_rcpf(g[3])}; }
#pragma unroll
        for (int ai = 0; ai < 2; ++ai) {
            u32x4 hv[4][2];
#pragma unroll
            for (int m = 0; m < 4; ++m) { const size_t off = (size_t)(u.pm * BM + ai * HALF + wr * 64 + m * 16 + fr) * DM + col0;
#pragma unroll
                for (int bj = 0; bj < 2; ++bj) hv[m][bj] = __builtin_nontemporal_load((const u32x4*)(h1 + off + bj * 32)); }
            asm volatile("" ::: "memory");
#pragma unroll
            for (int m = 0; m < 4; ++m) { const int trow = u.pm * BM + ai * HALF + wr * 64 + m * 16; const float sr = srp[ai * HALF + m * 16]; u32x4 w[2];
#pragma unroll
                for (int bj = 0; bj < 2; ++bj) { const u32x4 h = hv[m][bj];
                    const f32x4 x0 = (f32x4){bflo(h.x), bfhi(h.x), bflo(h.y), bfhi(h.y)} * (gi[bj][0] * sr), x1 = (f32x4){bflo(h.z), bfhi(h.z), bflo(h.w), bfhi(h.w)} * (gi[bj][1] * sr);
                    const f32x4 v0 = x0 + acc[ai][bj][m][0] * oscale + bv[bj][0], v1 = x1 + acc[ai][bj][m][1] * oscale + bv[bj][1];
                    w[bj].x = cvt_pk_bf16(v0[0], v0[1]); w[bj].y = cvt_pk_bf16(v0[2], v0[3]); w[bj].z = cvt_pk_bf16(v1[0], v1[1]); w[bj].w = cvt_pk_bf16(v1[2], v1[3]); }
                u32x4 dA, dB;
                dA.x = (unsigned)__builtin_amdgcn_update_dpp((int)w[0].x, (int)w[1].x, 0x128, 0xF, 0xC, false); dA.y = (unsigned)__builtin_amdgcn_update_dpp((int)w[0].y, (int)w[1].y, 0x128, 0xF, 0xC, false);
                dA.z = (unsigned)__builtin_amdgcn_update_dpp((int)w[0].z, (int)w[1].z, 0x128, 0xF, 0xC, false); dA.w = (unsigned)__builtin_amdgcn_update_dpp((int)w[0].w, (int)w[1].w, 0x128, 0xF, 0xC, false);
                dB.x = (unsigned)__builtin_amdgcn_update_dpp((int)w[1].x, (int)w[0].x, 0x128, 0xF, 0x3, false); dB.y = (unsigned)__builtin_amdgcn_update_dpp((int)w[1].y, (int)w[0].y, 0x128, 0xF, 0x3, false);
                dB.z = (unsigned)__builtin_amdgcn_update_dpp((int)w[1].z, (int)w[0].z, 0x128, 0xF, 0x3, false); dB.w = (unsigned)__builtin_amdgcn_update_dpp((int)w[1].w, (int)w[0].w, 0x128, 0xF, 0x3, false);
                bf16_t* dst = x1b + (size_t)(trow + (fr & 7)) * DM + u.pn * BM + wc * 64 + (fr < 8 ? 0 : 32) + 8 * fq;
                *(u32x4*)dst = dA; *(u32x4*)(dst + (size_t)8 * DM) = dB; }
        }
    }
};
typedef float f32x2 __attribute__((ext_vector_type(2)));
struct EpiSwiglu {
    static constexpr int PERM = 3;
    unsigned char* HID; const float* b1; const float* rsl; float oscale;
    __device__ __forceinline__ void stage(const Unit& u, LAS unsigned char* slot, int wid, int lane) const {
        if (wid == 0) __builtin_amdgcn_global_load_lds((const unsigned*)(b1 + (size_t)u.e * DU + u.pn * BM + 4 * lane), (LAS unsigned*)slot, 16, 0, 0);
        if (wid == 1) __builtin_amdgcn_global_load_lds((const unsigned*)(rsl + (size_t)u.e * NTOK + u.rt * BM + 4 * lane), (LAS unsigned*)(slot + 1024), 16, 0, 0);
    }
    __device__ __forceinline__ void operator()(const f32x4 (&acc)[2][2][4][2], const Unit& u, int wr, int wc, int fr, int fq, const LAS unsigned char* slot) const {
        const int ch = 2 * (fq & 1) + (fq >> 1);
        const LAS float* bsl = (const LAS float*)slot + wc * 64 + 16 * ch; const LAS float* rsp = (const LAS float*)(slot + 1024) + wr * 64 + fr;
        f32x4 bv[2][2];
#pragma unroll
        for (int bj = 0; bj < 2; ++bj)
#pragma unroll
            for (int n = 0; n < 2; ++n) { const f32x4 b = *(const LAS f32x4*)(bsl + 8 * bj + 4 * n); bv[bj][n] = (f32x4){b[0], b[2], __builtin_fmaf(b[1], HID_FP8_SCALE, HID_FP8_SCALE), __builtin_fmaf(b[3], HID_FP8_SCALE, HID_FP8_SCALE)}; }
        const bool up = fq >= 2;
        unsigned char* hrow = HID + (size_t)(u.pm * BM + wr * 64 + fr + (up ? 16 : 0)) * DFF + u.pn * (BM / 2) + wc * 32 + 16 * (fq & 1);
#pragma unroll
        for (int ai = 0; ai < 2; ++ai)
#pragma unroll
            for (int mp = 0; mp < 2; ++mp) { u32x2 w2[2];
#pragma unroll
                for (int mi = 0; mi < 2; ++mi) { const int m = 2 * mp + mi; f32x2 hv[4]; const float rs = rsp[ai * HALF + m * 16] * oscale, rss = rs * HID_FP8_SCALE; const f32x4 rs4 = (f32x4){rs, rs, rss, rss};
#pragma unroll
                    for (int bj = 0; bj < 2; ++bj)
#pragma unroll
                        for (int n = 0; n < 2; ++n) { const f32x4 v = acc[ai][bj][m][n] * rs4 + bv[bj][n];
                            const f32x2 g = (f32x2){fminf(v[0], 7.0f), fminf(v[1], 7.0f)};
                            const f32x2 l = (f32x2){__builtin_amdgcn_fmed3f(v[2], -6.0f * HID_FP8_SCALE, 8.0f * HID_FP8_SCALE), __builtin_amdgcn_fmed3f(v[3], -6.0f * HID_FP8_SCALE, 8.0f * HID_FP8_SCALE)};
                            const f32x2 t = g * (-1.702f * LOG2E);
                            const f32x2 d = (f32x2){__builtin_amdgcn_exp2f(t[0]), __builtin_amdgcn_exp2f(t[1])} + 1.0f;
                            const f32x2 r = (f32x2){__builtin_amdgcn_rcpf(d[0]), __builtin_amdgcn_rcpf(d[1])};
                            hv[2 * bj + n] = (g * r) * l; }
                    w2[mi].x = pk4_fp8(hv[0][0], hv[0][1], hv[1][0], hv[1][1]); w2[mi].y = pk4_fp8(hv[2][0], hv[2][1], hv[3][0], hv[3][1]); }
                u32x4 o;
                { const auto r0 = __builtin_amdgcn_permlane32_swap(w2[0].x, w2[1].x, false, false); const unsigned a0 = r0[0], b0 = r0[1];
                  const auto r1 = __builtin_amdgcn_permlane32_swap(w2[0].y, w2[1].y, false, false); const unsigned a1 = r1[0], b1 = r1[1];
                  o = (u32x4){a0, a1, b0, b1}; }
                *(u32x4*)(hrow + (size_t)(ai * HALF + mp * 32) * DFF) = o; }
    }
};
struct EpiY {
    static constexpr int PERM = 2;
    unsigned char* Y; const float* b2; float oscale;
    __device__ __forceinline__ void stage(const Unit& u, LAS unsigned char* slot, int wid, int lane) const {
        if (wid == 0) __builtin_amdgcn_global_load_lds((const unsigned*)(b2 + (size_t)u.e * DM + u.pn * BM + 4 * lane), (LAS unsigned*)slot, 16, 0, 0);
    }
    __device__ __forceinline__ void operator()(const f32x4 (&acc)[2][2][4][2], const Unit& u, int wr, int wc, int fr, int fq, const LAS unsigned char* slot) const {
        const int col0 = u.pn * BM + wc * 64 + 16 * fq;
        const LAS float* bsl = (const LAS float*)slot + wc * 64 + 16 * fq;
        f32x4 bv[2][2];
#pragma unroll
        for (int bj = 0; bj < 2; ++bj)
#pragma unroll
            for (int n = 0; n < 2; ++n) bv[bj][n] = *(const LAS f32x4*)(bsl + 8 * bj + 4 * n) * Y_FP8_SCALE;
        const float os = oscale * Y_FP8_SCALE;
#pragma unroll
        for (int ai = 0; ai < 2; ++ai)
#pragma unroll
            for (int m = 0; m < 4; ++m) { u32x4 w;
                { const f32x4 v = acc[ai][0][m][0] * os + bv[0][0]; w.x = pk4_fp8(v[0], v[1], v[2], v[3]); }
                { const f32x4 v = acc[ai][0][m][1] * os + bv[0][1]; w.y = pk4_fp8(v[0], v[1], v[2], v[3]); }
                { const f32x4 v = acc[ai][1][m][0] * os + bv[1][0]; w.z = pk4_fp8(v[0], v[1], v[2], v[3]); }
                { const f32x4 v = acc[ai][1][m][1] * os + bv[1][1]; w.w = pk4_fp8(v[0], v[1], v[2], v[3]); }
                *(u32x4*)(Y + (size_t)(u.pm * BM + ai * HALF + wr * 64 + m * 16 + fr) * DM + col0) = w; }
    }
};
}

#define GAS __attribute__((address_space(1)))
typedef GAS unsigned gu32;
#define RLX_AGENT __ATOMIC_RELAXED, __HIP_MEMORY_SCOPE_AGENT
#define XB_TMO      128
#define XB_XCNT(j)  (256  + 64 * (j))
#define XB_XSUB(j)  (1280 + 64 * (j))
#define XB_XGEN(j)  (2304 + 64 * (j))
#define XB_TOP      3328
#define XB_TOPGEN   3392
#define XCD_BAR_WORDS 3456
#define XB_SPIN_CAP (1u << 18)

__device__ __forceinline__ unsigned xb_ld(unsigned* p)              { return __hip_atomic_load(p, __ATOMIC_RELAXED, __HIP_MEMORY_SCOPE_AGENT); }
__device__ __forceinline__ unsigned xb_add(unsigned* p, unsigned v) { return __hip_atomic_fetch_add(p, v, __ATOMIC_RELAXED, __HIP_MEMORY_SCOPE_AGENT); }
__device__ __forceinline__ unsigned xb_xcc_id() { return (unsigned)__builtin_amdgcn_s_getreg((3 << 11) | 20) & 0xFu; }
#define XB_SPIN(cond, bar) do { unsigned _sp = 0; while (cond) { __builtin_amdgcn_s_sleep(1); \
    if ((++_sp & 255u) == 0u) { if (xb_ld(&(bar)[XB_TMO])) break; if (_sp > XB_SPIN_CAP) { atomicAdd(&(bar)[XB_TMO], 1u); break; } } } } while (0)

struct XcdBarrier {
    unsigned* bar; unsigned x;
    volatile LAS unsigned* st;
};

__device__ __forceinline__ XcdBarrier xcd_barrier_post(unsigned* bar, volatile LAS unsigned* st) {
    XcdBarrier b; b.bar = bar; b.x = xb_xcc_id(); b.st = st;
    if (threadIdx.x == 0) (void)xb_add(&bar[XB_XCNT(b.x)], 1u);
    return b;
}
__device__ __forceinline__ void xcd_barrier_complete(unsigned* bar, unsigned x, unsigned& nloc, unsigned& nx) {
    const unsigned G = gridDim.x * gridDim.y * gridDim.z;
    unsigned sum, cnt, mine, sp = 0u;
    for (;;) {
        sum = 0u; cnt = 0u; mine = 0u;
#pragma unroll
        for (unsigned j = 0; j < 16; ++j) { const unsigned c = xb_ld(&bar[XB_XCNT(j)]); sum += c; cnt += (c > 0u) ? 1u : 0u; mine = (j == x) ? c : mine; }
        if (sum == G) break;
        __builtin_amdgcn_s_sleep(1);
        if ((++sp & 255u) == 0u) { if (xb_ld(&bar[XB_TMO])) break; if (sp > XB_SPIN_CAP) { atomicAdd(&bar[XB_TMO], 1u); break; } }
    }
    nloc = mine > 0u ? mine : 1u; nx = cnt > 0u ? cnt : 1u;
}

template <class Work>
__device__ __forceinline__ void xcd_barrier(const XcdBarrier& b, const Work& work) {
    asm volatile("s_waitcnt vmcnt(0)" ::: "memory");
    __syncthreads();
    if (threadIdx.x >= 64) work();
    if (threadIdx.x == 0) {
        unsigned* bar = b.bar;
        __builtin_amdgcn_s_waitcnt(0);
        unsigned nloc = b.st[0], nx = b.st[1];
        if (nloc == 0u) { xcd_barrier_complete(bar, b.x, nloc, nx); b.st[0] = nloc; b.st[1] = nx; }
        const unsigned round = b.st[2]; b.st[2] = round + 1u;
        const unsigned old = xb_add(&bar[XB_XSUB(b.x)], 1u);
        const unsigned gen = old / nloc;
        if (old + 1u == (gen + 1u) * nloc) {
            __builtin_amdgcn_fence(__ATOMIC_RELEASE, "agent");
            asm volatile("s_waitcnt vmcnt(0)" ::: "memory");
            (void)xb_add(&bar[XB_TOP], 1u);
        }
        const unsigned target = (round + 1u) * nx;
        __builtin_amdgcn_fence(__ATOMIC_ACQUIRE, "agent");
        XB_SPIN(xb_ld(&bar[XB_TOP]) < target, bar);
        asm volatile("s_waitcnt vmcnt(0)" ::: "memory");
    }
    __syncthreads();
}


__device__ __forceinline__ int expert_table_lds(const unsigned* cnt, LAS int* tab, int lane, int wave) {
    int mycnt, myts; expert_tiles(cnt, lane, mycnt, myts);
    if (wave == 0 && lane < 32) { tab[lane] = myts; tab[32 + lane] = mycnt; }
    __syncthreads();
    return __builtin_amdgcn_readfirstlane(__shfl(myts, 31) + ((__shfl(mycnt, 31) + 255) >> 8));
}

constexpr int NWAVES = 8;
constexpr int LDS_BYTES = 147456;
constexpr int MISC_OFF = 131072 + 320;
constexpr int TAB_OFF = 131072 + 10240;
constexpr int CW_BAR = 4096;
#ifndef MK_N_LAUNCHES
#define MK_N_LAUNCHES 1
#endif
constexpr int N_PHASES = 9;
struct Args { Params P; int ph_lo, ph_hi; };

__global__ void __launch_bounds__(NWAVES * 64, 2) mk_fwd(Args args) {
    extern __shared__ __attribute__((aligned(16))) unsigned char lds[];
    const Params& P = args.P;
    const int tid = threadIdx.x, lane = tid & 63, wave = __builtin_amdgcn_readfirstlane(tid >> 6);
    const int gw = blockIdx.x * NWAVES + wave, ngw = gridDim.x * NWAVES;
    volatile LAS unsigned* MISC = (volatile LAS unsigned*)((LAS unsigned char*)lds + MISC_OFF);
    for (int u = tid; u < 64; u += NWAVES * 64) MISC[u] = 0u;
    __syncthreads();
    XcdBarrier bar; bar.bar = (unsigned*)(P.ws + WS_CTL) + CW_BAR; bar.x = 0; bar.st = nullptr;
    const int lo = args.ph_lo, hi = args.ph_hi;
    if (hi - lo > 1) bar = xcd_barrier_post((unsigned*)(P.ws + WS_CTL) + CW_BAR, MISC + 8);
#define IN(k) (lo <= (k) && (k) < hi)
    const bool split_p1 = (gridDim.x == 256) && IN(0) && IN(1);
    constexpr int CONV_Y0 = 24, TI_P0X = 4500, TI_Q = 4000, TI_P0 = TI_IN + TI_OUT + TI_P0X;
    constexpr int N_SEAM_ITEMS = 5, TI_SEAM = N_SEAM_ITEMS * 256 * (NWAVES - 1), TI_R0 = TI_P0 + TI_SEAM;
    auto seam_work = [&](int k) { if (split_p1 && k < N_SEAM_ITEMS) { const int it = TI_P0 + k * (256 * (NWAVES - 1)) + (int)blockIdx.x * (NWAVES - 1) + (wave - 1); const int r = it - TI_IN - TI_OUT, e = r / TI_1; transpose_item<true>(P.w1 + (size_t)e * DM * DU, DM, DU, P.ws + WS_W1 + (size_t)e * DU * DM, false, (LAS float*)lds + wave * (64 * 36), r % TI_1, lane); } };
#define SEAM(k) do { if (IN(k) && IN((k) + 1)) xcd_barrier(bar, [&]() { seam_work(k); }); } while (0)
#define RUN(k, ...) do { if (IN(k)) { __VA_ARGS__; } } while (0)
    RUN(0, p0_prologue(P, gw, ngw, lane, (LAS float*)lds + wave * (64 * 36), split_p1 ? TI_P0 : TI_ALL));
    SEAM(0);
    RUN(1, {
        const int xl = (int)blockIdx.x & 7, yl = (int)blockIdx.x >> 3;
        if (split_p1 && yl >= CONV_Y0) weight_items(P, TI_R0, TI_ALL - TI_Q, ((yl - CONV_Y0) * 8 + xl) * NWAVES + wave, (32 - CONV_Y0) * 8 * NWAVES, lane, (LAS float*)lds + wave * (64 * 36));
        else {
            pg8::DenseOrder S; S.init(P.ws + WS_H1, P.ws + WS_WIN, NTOK, D_IN, DM * 2, split_p1 ? CONV_Y0 * 8 : (int)gridDim.x, split_p1 ? yl * 8 + xl : (int)blockIdx.x);
            const _Float16* RC = (const _Float16*)(P.ws + WS_ROPE);
            pg8::EpiQKV E{(bf16_t*)(P.ws + WS_QKV), P.b_in, RC, RC + (size_t)NTOK * 32};
            pg8::gemm_phase<false, false, pg8::EpiQKV, pg8::DenseOrder, true>((LAS unsigned char*)lds, DM * 2, S, E);
        }
    });
    SEAM(1);
    RUN(2, att::attn_phase(P, (LAS unsigned char*)lds, tid, lane, wave));
    SEAM(2);
    RUN(3, p2b_merge(P, gw, ngw, lane));
    SEAM(3);
    RUN(4, {
        pg8::DenseOrder S; S.init(P.ws + WS_MIXED, P.ws + WS_WOUT, NTOK, DM, DM, (int)gridDim.x, (int)blockIdx.x);
        pg8::EpiOut E{(const bf16_t*)(P.ws + WS_H1), (const float*)(P.ws + WS_SR1), P.g1, (bf16_t*)(P.ws + WS_X1B), P.b_out, 1.0f / (W_FP8_SCALE * MIX_FP8_SCALE)};
        pg8::gemm_phase<false, true, pg8::EpiOut, pg8::DenseOrder, true>((LAS unsigned char*)lds, DM, S, E);
    });
    SEAM(4);
    RUN(5, route::route_phase(P, (LAS unsigned char*)lds, tid, lane, wave));
    SEAM(5);
    RUN(6, {
        LAS int* tab = (LAS int*)((LAS unsigned char*)lds + TAB_OFF);
        const int NT = expert_table_lds((const unsigned*)(P.ws + WS_CTL) + CW_CNT, tab, lane, wave);
        pg8::GroupedOrder S{(const char*)(P.ws + WS_H2), (const char*)(P.ws + WS_W1), (const int*)(P.ws + WS_TOKL), tab, NT, DU / 256, (int)gridDim.x, (int)blockIdx.x, DM, DM, (size_t)DU * DM};
        pg8::EpiSwiglu E{(unsigned char*)(P.ws + WS_HID), P.b1, (const float*)(P.ws + WS_RSL), 1.0f / (W_FP8_SCALE * H2_FP8_SCALE)};
        pg8::gemm_phase<true, true, pg8::EpiSwiglu, pg8::GroupedOrder, true>((LAS unsigned char*)lds, DM, S, E);
        if (split_p1) {
            __syncthreads();
            const int rem = (NT * (DU / 256)) & 255, c = (int)blockIdx.x, nidle = rem ? 256 - rem : 0, nA = min(TI_Q, nidle * NWAVES * 4), q0 = TI_ALL - TI_Q;
            if (rem && c >= rem) weight_items(P, q0, q0 + nA, (c - rem) * NWAVES + wave, nidle * NWAVES, lane, (LAS float*)lds + wave * (64 * 36));
            weight_items(P, q0 + nA, TI_ALL, c * NWAVES + wave, 256 * NWAVES, lane, (LAS float*)lds + wave * (64 * 36));
        }
    });
    SEAM(6);
    RUN(7, {
        LAS int* tab = (LAS int*)((LAS unsigned char*)lds + TAB_OFF);
        const int NT = expert_table_lds((const unsigned*)(P.ws + WS_CTL) + CW_CNT, tab, lane, wave);
        pg8::GroupedOrder S{(const char*)(P.ws + WS_HID), (const char*)(P.ws + WS_W2), nullptr, tab, NT, DM / 256, (int)gridDim.x, (int)blockIdx.x, DFF, DFF, (size_t)DM * DFF};
        pg8::EpiY E{(unsigned char*)(P.ws + WS_Y), P.b2, 1.0f / (W_FP8_SCALE * HID_FP8_SCALE)};
        pg8::gemm_phase<false, true, pg8::EpiY, pg8::GroupedOrder, true>((LAS unsigned char*)lds, DFF, S, E);
    });
    SEAM(7);
    RUN(8, p7_combine(P, (LAS unsigned char*)lds, gw, ngw, lane, P.out));
#undef IN
#undef SEAM
#undef RUN
}

extern "C" void kernel_launch(void* const* d_in, const int* in_sizes, int n_in, void* d_out, int out_size, void* d_ws, size_t ws_size, hipStream_t stream) {
    static int grid = 0;
    if (grid == 0) {
        if (n_in != 18 || out_size != NTOK * DM || ws_size < WS_END) { fprintf(stderr, "kernel_launch: unexpected shapes (n_in %d out %d ws %zu)\n", n_in, out_size, ws_size); grid = -1; return; }
        int dev = 0, cus = 0, per_cu = 0;
        if (hipGetDevice(&dev) != hipSuccess || hipDeviceGetAttribute(&cus, hipDeviceAttributeMultiprocessorCount, dev) != hipSuccess) { fprintf(stderr, "kernel_launch: device query failed\n"); grid = -1; return; }
        if (hipFuncSetAttribute((const void*)mk_fwd, hipFuncAttributeMaxDynamicSharedMemorySize, LDS_BYTES) != hipSuccess) { fprintf(stderr, "kernel_launch: hipFuncSetAttribute failed\n"); grid = -1; return; }
        if (hipOccupancyMaxActiveBlocksPerMultiprocessor(&per_cu, (const void*)mk_fwd, NWAVES * 64, LDS_BYTES) != hipSuccess || per_cu < 1) { fprintf(stderr, "kernel_launch: occupancy query says %d blocks/CU; nothing launched\n", per_cu); (void)hipGetLastError(); grid = -1; return; }
        grid = cus;
    }
    if (grid < 0) return;
    Args a{};
    Params& P = a.P;
    P.x = (const float*)d_in[0]; P.pos = (const int*)d_in[1]; P.g1 = (const float*)d_in[2]; P.w_in = (const float*)d_in[3]; P.b_in = (const float*)d_in[4];
    P.sinks = (const float*)d_in[5]; P.gn_dil = (const float*)d_in[6]; P.gn_swa = (const float*)d_in[7]; P.w_out = (const float*)d_in[8]; P.b_out = (const float*)d_in[9];
    P.g2 = (const float*)d_in[10]; P.w_router = (const float*)d_in[11]; P.b_router = (const float*)d_in[12]; P.w1 = (const float*)d_in[13]; P.b1 = (const float*)d_in[14];
    P.w2 = (const float*)d_in[15]; P.b2 = (const float*)d_in[16]; P.gf = (const float*)d_in[17]; P.out = (float*)d_out; P.ws = (unsigned char*)d_ws;
    (void)hipMemsetAsync((char*)d_ws + WS_CTL, 0, CTL_BYTES, stream);
#if MK_N_LAUNCHES == 1
    a.ph_lo = 0; a.ph_hi = N_PHASES;
    hipLaunchKernelGGL(mk_fwd, dim3(grid), dim3(NWAVES * 64), LDS_BYTES, stream, a);
#else
    for (int k = 0; k < N_PHASES; ++k) { a.ph_lo = k; a.ph_hi = k + 1; hipLaunchKernelGGL(mk_fwd, dim3(grid), dim3(NWAVES * 64), LDS_BYTES, stream, a); }
#endif
}
```
